# Optimizing an MI355X kernel written in HIP

```python
import math
import jax, jax.numpy as jnp
from jax import lax
import numpy as np

D_MODEL = 1024
BATCH = 16
SEQ = 2048
DEPTH = 1

MIX_WIDTH = D_MODEL
ATTN_WIDTH = D_MODEL // 2
SGU_WIDTH = MIX_WIDTH - ATTN_WIDTH
HEAD_DIM = 64
N_HEADS = ATTN_WIDTH // HEAD_DIM
N_KV = 2
GQ = N_HEADS // N_KV
KV_WIDTH = N_KV * HEAD_DIM
WINDOW = 128
BLK = 128
SGU_GROUPS = 8
SGU_GROUP_DIM = SGU_WIDTH // SGU_GROUPS
CHUNK = 128
D_FF = ((8 * D_MODEL // 3) + 127) // 128 * 128
CONV_WIDTH = 3
PLE_DIM = 256
IN_WIDTH = ATTN_WIDTH + 2 * KV_WIDTH + 2 * SGU_WIDTH
RMS_EPS = 1e-6
LN_EPS = 1e-5
NEG_INF = -1e30

kernel_name = "hymba_style_swa_sgu_convffn_ple_encoder"


def rmsnorm(x, g):
    xf = x.astype(jnp.float32)
    y = xf * lax.rsqrt(jnp.mean(xf * xf, axis=-1, keepdims=True) + RMS_EPS)
    return (y * g.astype(jnp.float32)).astype(x.dtype)


def layernorm(x, g, b):
    xf = x.astype(jnp.float32)
    mu = jnp.mean(xf, axis=-1, keepdims=True)
    var = jnp.mean(jnp.square(xf - mu), axis=-1, keepdims=True)
    y = (xf - mu) * lax.rsqrt(var + LN_EPS)
    return (y * g.astype(jnp.float32) + b.astype(jnp.float32)).astype(x.dtype)


def alibi_slopes(n_heads):
    return jnp.exp2(-8.0 * jnp.arange(1, n_heads + 1, dtype=jnp.float32) / n_heads)


def band_blocks(t, nb):
    b = t.shape[0]
    tp = jnp.pad(t, ((0, 0), (BLK, BLK), (0, 0), (0, 0)))
    tp = tp.reshape(b, nb + 2, BLK, t.shape[2], t.shape[3])
    return jnp.concatenate([tp[:, :-2], tp[:, 1:-1], tp[:, 2:]], axis=2)


def windowed_gqa(q, k, v, sink):
    b, s = q.shape[0], q.shape[1]
    nb = s // BLK
    qb = q.reshape(b, nb, BLK, N_KV, GQ, HEAD_DIM)
    kb = band_blocks(k, nb)
    vb = band_blocks(v, nb)
    scores = jnp.einsum('bnqkgd,bnskd->bnkgqs', qb, kb).astype(jnp.float32)
    scores = scores * (HEAD_DIM ** -0.5)
    qi = jnp.arange(BLK)[:, None]
    kj = jnp.arange(3 * BLK)[None, :]
    dist = jnp.abs(qi + BLK - kj)
    key_pos = jnp.arange(nb)[:, None] * BLK - BLK + jnp.arange(3 * BLK)[None, :]
    valid = (dist <= WINDOW)[None] & ((key_pos >= 0) & (key_pos < s))[:, None, :]
    slopes = alibi_slopes(N_HEADS).reshape(N_KV, GQ)
    bias = -slopes[:, :, None, None] * dist.astype(jnp.float32)
    scores = jnp.where(valid[None, :, None, None], scores + bias[None, None], NEG_INF)
    sink_l = sink.astype(jnp.float32).reshape(N_KV, GQ)[None, None, :, :, None, None]
    m = jnp.maximum(jnp.max(scores, axis=-1, keepdims=True), sink_l)
    e = jnp.exp(scores - m)
    denom = jnp.sum(e, axis=-1, keepdims=True) + jnp.exp(sink_l - m)
    probs = (e / denom).astype(v.dtype)
    o = jnp.einsum('bnkgqs,bnskd->bnqkgd', probs, vb)
    return o.reshape(b, s, N_HEADS * HEAD_DIM)


def chunked_sgu(zu, zv, ln_g, ln_b, w_s, b_s):
    b, s = zu.shape[0], zu.shape[1]
    nc = s // CHUNK
    u = jax.nn.gelu(zu, approximate=True)
    vv = layernorm(jax.nn.gelu(zv, approximate=True), ln_g, ln_b)
    vv = vv.reshape(b, nc, CHUNK, SGU_GROUPS, SGU_GROUP_DIM)
    mixed = jnp.einsum('hts,bnshc->bnthc', w_s, vv) + b_s.T[None, None, :, :, None]
    return u * mixed.reshape(b, s, SGU_WIDTH)


def dwconv3_centred(h, w, bias):
    hp = jnp.pad(h, ((0, 0), (1, 1), (0, 0)))
    return hp[:, :-2] * w[0] + hp[:, 1:-1] * w[1] + hp[:, 2:] * w[2] + bias


def setup_inputs(seed: int = 0) -> dict:
    key = jax.random.key(seed)
    ks = jax.random.split(key, 24)
    f32 = jnp.float32
    nrm = lambda k, shape, scale: jax.random.normal(k, shape, f32) * scale
    gain = lambda k, shape: 1.0 + 0.02 * jax.random.normal(k, shape, f32)
    return {
        "x": jax.random.normal(ks[0], (BATCH, SEQ, D_MODEL), f32),
        "p": jax.random.normal(ks[1], (DEPTH, BATCH, SEQ, PLE_DIM), f32),
        "g_mix": gain(ks[2], (DEPTH, D_MODEL)),
        "w_in": nrm(ks[3], (DEPTH, D_MODEL, IN_WIDTH), D_MODEL ** -0.5),
        "attn_sink": nrm(ks[4], (DEPTH, N_HEADS), 0.5),
        "sgu_ln_g": gain(ks[5], (DEPTH, SGU_WIDTH)),
        "sgu_ln_b": nrm(ks[6], (DEPTH, SGU_WIDTH), 0.02),
        "sgu_w": nrm(ks[7], (DEPTH, SGU_GROUPS, CHUNK, CHUNK), CHUNK ** -0.5),
        "sgu_b": 1.0 + nrm(ks[8], (DEPTH, SGU_GROUPS, CHUNK), 0.02),
        "g_attn_out": gain(ks[9], (DEPTH, ATTN_WIDTH)),
        "g_sgu_out": gain(ks[10], (DEPTH, SGU_WIDTH)),
        "w_out": nrm(ks[11], (DEPTH, MIX_WIDTH, D_MODEL), MIX_WIDTH ** -0.5),
        "g_ffn": gain(ks[12], (DEPTH, D_MODEL)),
        "w_up": nrm(ks[13], (DEPTH, D_MODEL, 2 * D_FF), D_MODEL ** -0.5),
        "conv_w": nrm(ks[14], (DEPTH, CONV_WIDTH, D_FF), CONV_WIDTH ** -0.5),
        "conv_b": nrm(ks[15], (DEPTH, D_FF), 0.02),
        "w_down": nrm(ks[16], (DEPTH, D_FF, D_MODEL), D_FF ** -0.5),
        "g_ple": gain(ks[17], (DEPTH, D_MODEL)),
        "w_ple_gate": nrm(ks[18], (DEPTH, D_MODEL, D_MODEL), D_MODEL ** -0.5),
        "w_ple_proj": nrm(ks[19], (DEPTH, PLE_DIM, D_MODEL), PLE_DIM ** -0.5),
        "g_final": gain(ks[20], (D_MODEL,)),
    }


def reference(x, p, g_mix, w_in, attn_sink, sgu_ln_g, sgu_ln_b, sgu_w, sgu_b,
              g_attn_out, g_sgu_out, w_out, g_ffn, w_up, conv_w, conv_b, w_down,
              g_ple, w_ple_gate, w_ple_proj, g_final):
    b, s, _ = x.shape
    h = x
    splits = [ATTN_WIDTH, ATTN_WIDTH + KV_WIDTH, ATTN_WIDTH + 2 * KV_WIDTH,
              ATTN_WIDTH + 2 * KV_WIDTH + SGU_WIDTH]
    for i in range(DEPTH):
        a = rmsnorm(h, g_mix[i])
        z = a @ w_in[i]
        q, k, v, zu, zv = jnp.split(z, splits, axis=-1)
        q = q.reshape(b, s, N_HEADS, HEAD_DIM)
        k = k.reshape(b, s, N_KV, HEAD_DIM)
        v = v.reshape(b, s, N_KV, HEAD_DIM)
        attn_o = windowed_gqa(q, k, v, attn_sink[i])
        sgu_o = chunked_sgu(zu, zv, sgu_ln_g[i], sgu_ln_b[i], sgu_w[i], sgu_b[i])
        merged = jnp.concatenate([rmsnorm(attn_o, g_attn_out[i]),
                                  rmsnorm(sgu_o, g_sgu_out[i])], axis=-1)
        h = h + merged @ w_out[i]
        c = rmsnorm(h, g_ffn[i])
        gate, val = jnp.split(c @ w_up[i], 2, axis=-1)
        gate = dwconv3_centred(gate, conv_w[i], conv_b[i])
        h = h + (jax.nn.gelu(gate, approximate=True) * val) @ w_down[i]
        pg = jax.nn.sigmoid(rmsnorm(h, g_ple[i]) @ w_ple_gate[i])
        h = h + (p[i] @ w_ple_proj[i]) * pg
    return rmsnorm(h, g_final)
```

```cpp
#include <hip/hip_runtime.h>
#include <hip/hip_cooperative_groups.h>
#include <cstdio>
#include <cstdint>
namespace cg = cooperative_groups;
namespace pg8 {
#define PG8_LAS __attribute__((address_space(3)))
typedef unsigned short bf16_t;
typedef short bf16x8 __attribute__((ext_vector_type(8)));
typedef float f32x4 __attribute__((ext_vector_type(4)));
typedef unsigned u32x4 __attribute__((ext_vector_type(4)));
constexpr int BM = 256, BK = 64, HALF = 128, HTB = HALF * BK * 2  , STAGE_BYTES = 8 * HTB, NXCD = 8, WGM = 8;

__host__ __device__ __forceinline__ int lds_byte(int r, int c) { const int st = (r >> 4) * 2 + (c >> 5), rr = r & 15, cc = c & 31, ob = rr * 64 + cc * 2; return st * 1024 + (ob ^ (((ob >> 9) & 1) << 5)); }
__host__ __device__ __forceinline__ void stage_rc(int b, int& R, int& C) { const int st = b / 1024, sb = b % 1024, swz = sb ^ (((sb >> 9) & 1) << 5); R = (st >> 1) * 16 + swz / 64; C = (st & 1) * 32 + (swz % 64) / 2; }
__host__ __device__ __forceinline__ int perm32(int rho) { const int n = rho >> 4, i = rho & 15; return 8 * (i >> 2) + 4 * n + (i & 3); }

struct Unit { int pm, pn; };
struct Gemm { const bf16_t* A; const bf16_t* Bt; int M, N, K; };

struct StaticOrder {
    int nM, nN, nwg, G, c, wgm;
    __host__ __device__ void init(int M, int N, int G_, int c_, int wgm_ = WGM) { nM = M / BM; nN = N / BM; nwg = nM * nN; G = G_; c = c_; wgm = wgm_; }
    __host__ __device__ bool next(int i, Unit& u) const {
        const long L = (long)i * G + c; if (L >= nwg) return false;
        int wgid = (int)L; { const int q = nwg / NXCD, r = nwg % NXCD, xcd = wgid % NXCD, off = wgid / NXCD; wgid = (xcd < r ? xcd * (q + 1) : r * (q + 1) + (xcd - r) * q) + off; }
        const int nig = wgm * nN, gid = wgid / nig, fm = gid * wgm, gsz = (nM - fm) < wgm ? (nM - fm) : wgm;
        u.pm = fm + ((wgid % nig) % gsz); u.pn = (wgid % nig) / gsz; return true;
    }
    __device__ __forceinline__ void a_ready(const Unit&) const {}
    __device__ __forceinline__ void done(const Unit&) const {}
};

__device__ __forceinline__ unsigned cvt_pk_bf16(float lo, float hi) { unsigned r; asm volatile("v_cvt_pk_bf16_f32 %0, %1, %2" : "=v"(r) : "v"(lo), "v"(hi)); return r; }
typedef float f32x2 __attribute__((ext_vector_type(2)));
template <class Epi, class Sched, bool ALIGN_EPI = false, bool SP2 = false>
__device__ __forceinline__ void gemm_phase(PG8_LAS unsigned char* lds, const Gemm g, const Sched& S, const Epi& E) {
    int tid_ = threadIdx.x; asm volatile("" : "+v"(tid_));
    const int tid = tid_, wid = __builtin_amdgcn_readfirstlane(tid >> 6), lane = tid & 63, wr = wid >> 2, wc = wid & 3, fr = lane & 15, fq = lane >> 4;
    const int K = g.K, nt = K / BK;
    unsigned voffA[2], voffB[2];
#pragma unroll
    for (int i = 0; i < 2; ++i) { int R, C; stage_rc(tid * 16 + i * 8192, R, C); const int Rb = Epi::PERM ? ((R & ~31) + perm32(R & 31)) : R;
        const int Ra = Epi::PERMA ? ((R & ~63) + 4 * (R & 15) + ((R >> 4) & 3)) : R;
        voffA[i] = (unsigned)(Ra * K + C) * 2u; voffB[i] = (unsigned)(Rb * K + C) * 2u; }
    const size_t kstep = (size_t)(BK * 2);
    const size_t hstep = (size_t)HALF * K * 2;
    const size_t tstep = 2 * hstep;
    const unsigned ldsw = (unsigned)wid * 1024u;
    const int aoff = lds_byte(wr * 64 + fr, fq * 8), boff = lds_byte(wc * 32 + fr, fq * 8);
#define PG8_SA(b, h) (((b) * 2 + (h)) * HTB)
#define PG8_SB(b, h) ((4 + (b) * 2 + (h)) * HTB)
#define PG8_STAGE(bufoff, gbase, voff) do { _Pragma("unroll") for (int _i = 0; _i < 2; ++_i) \
        __builtin_amdgcn_global_load_lds((const unsigned*)((const char*)(gbase) + (voff)[_i]), (PG8_LAS unsigned*)(lds + (bufoff) + ldsw + _i * 8192), 16, 0, 0); } while (0)
#define PG8_LDA(dst, b, h) do { _Pragma("unroll") for (int m = 0; m < 4; ++m) _Pragma("unroll") for (int k = 0; k < 2; ++k) dst[m][k] = *(const PG8_LAS bf16x8*)(lds + PG8_SA(b, h) + aoff + m * 2048 + k * 1024); } while (0)
#define PG8_LDB(dst, b, h) do { _Pragma("unroll") for (int n = 0; n < 2; ++n) _Pragma("unroll") for (int k = 0; k < 2; ++k) dst[n][k] = *(const PG8_LAS bf16x8*)(lds + PG8_SB(b, h) + boff + n * 2048 + k * 1024); } while (0)
#define PG8_MMA(ai, bj, At, Bt) do { __builtin_amdgcn_s_setprio(1); _Pragma("unroll") for (int m = 0; m < 4; ++m) _Pragma("unroll") for (int n = 0; n < 2; ++n) _Pragma("unroll") for (int k = 0; k < 2; ++k) \
        acc[ai][bj][m][n] = __builtin_amdgcn_mfma_f32_16x16x32_bf16(Bt[n][k], At[m][k], acc[ai][bj][m][n], 0, 0, 0); __builtin_amdgcn_s_setprio(0); } while (0)
#define PG8_WAIT_V(n) asm volatile("s_waitcnt vmcnt(" #n ")" ::: "memory")
#define PG8_WAIT_L(n) asm volatile("s_waitcnt lgkmcnt(" #n ")" ::: "memory")
#define PG8_BAR __builtin_amdgcn_s_barrier()
#define PG8_SCHED __builtin_amdgcn_sched_barrier(0)
    Unit cur, nxt; int ui = 0;
    if (!S.next(0, cur)) return;
    f32x4 acc[2][2][4][2];
#pragma unroll
    for (int a = 0; a < 2; ++a)
#pragma unroll
        for (int b = 0; b < 2; ++b)
#pragma unroll
            for (int m = 0; m < 4; ++m)
#pragma unroll
                for (int n = 0; n < 2; ++n) acc[a][b][m][n] = (f32x4){0.f, 0.f, 0.f, 0.f};
    bf16x8 At[4][2], B0[2][2], B1[2][2];
    const char* cA = (const char*)g.A + (size_t)cur.pm * tstep; const char* cB = (const char*)g.Bt + (size_t)cur.pn * tstep;
    S.a_ready(cur);
    if constexpr (SP2) {
        PG8_STAGE(PG8_SB(0, 0), cB, voffB); PG8_STAGE(PG8_SB(0, 1), cB + hstep, voffB); PG8_STAGE(PG8_SA(0, 0), cA, voffA); PG8_STAGE(PG8_SA(0, 1), cA + hstep, voffA);
        if (wr == 1) PG8_BAR;
        PG8_WAIT_V(2); PG8_BAR;
        PG8_STAGE(PG8_SB(1, 0), cB + kstep, voffB); PG8_STAGE(PG8_SA(1, 0), cA + kstep, voffA); PG8_STAGE(PG8_SB(1, 1), cB + hstep + kstep, voffB);
        PG8_WAIT_V(6); PG8_BAR;
    } else {
        PG8_STAGE(PG8_SB(0, 0), cB, voffB); PG8_STAGE(PG8_SA(0, 0), cA, voffA); PG8_STAGE(PG8_SB(0, 1), cB + hstep, voffB); PG8_STAGE(PG8_SA(0, 1), cA + hstep, voffA);
        if (wr == 1) PG8_BAR;
        PG8_WAIT_V(4); PG8_BAR;
        PG8_STAGE(PG8_SB(1, 0), cB + kstep, voffB); PG8_STAGE(PG8_SA(1, 0), cA + kstep, voffA); PG8_STAGE(PG8_SB(1, 1), cB + hstep + kstep, voffB);
        PG8_WAIT_V(6); PG8_BAR;
    }
    for (;;) {
        const bool has_next = S.next(ui + 1, nxt);
        const char* nA = has_next ? (const char*)g.A + (size_t)nxt.pm * tstep : cA; const char* nB = has_next ? (const char*)g.Bt + (size_t)nxt.pn * tstep : cB;
        for (int t = 0; t < nt; t += 2) {
            const bool last = (t == nt - 2);
            const char* a1 = cA + (size_t)(t + 1) * kstep;
            const char* a2 = last ? nA : cA + (size_t)(t + 2) * kstep; const char* b2 = last ? nB : cB + (size_t)(t + 2) * kstep;
            const char* a3 = a2 + kstep; const char* b3 = b2 + kstep;
            if (last && has_next) S.a_ready(nxt);
            if constexpr (SP2) {
            PG8_LDB(B0, 0, 0); PG8_LDB(B1, 0, 1); PG8_SCHED; PG8_LDA(At, 0, 0); PG8_STAGE(PG8_SA(1, 1), a1 + hstep, voffA);
            PG8_WAIT_V(8); PG8_WAIT_L(0); PG8_BAR; PG8_MMA(0, 0, At, B0); PG8_MMA(0, 1, At, B1); PG8_BAR; PG8_SCHED;
            PG8_LDA(At, 0, 1); PG8_STAGE(PG8_SB(0, 0), b2, voffB); PG8_STAGE(PG8_SB(0, 1), b2 + hstep, voffB); PG8_STAGE(PG8_SA(0, 0), a2, voffA);
            PG8_WAIT_V(8); PG8_WAIT_L(0); PG8_BAR; PG8_MMA(1, 0, At, B0); PG8_MMA(1, 1, At, B1); PG8_BAR; PG8_SCHED;
            PG8_LDB(B0, 1, 0); PG8_LDB(B1, 1, 1); PG8_SCHED; PG8_LDA(At, 1, 0); PG8_STAGE(PG8_SA(0, 1), a2 + hstep, voffA);
            PG8_WAIT_V(8); PG8_WAIT_L(0); PG8_BAR; PG8_MMA(0, 0, At, B0); PG8_MMA(0, 1, At, B1); PG8_BAR; PG8_SCHED;
            PG8_LDA(At, 1, 1); PG8_STAGE(PG8_SB(1, 0), b3, voffB); PG8_STAGE(PG8_SB(1, 1), b3 + hstep, voffB); PG8_STAGE(PG8_SA(1, 0), a3, voffA);
            PG8_WAIT_V(8); PG8_WAIT_L(0); PG8_BAR; PG8_MMA(1, 0, At, B0); PG8_MMA(1, 1, At, B1); PG8_BAR; PG8_SCHED;
            } else {
            PG8_LDB(B0, 0, 0); PG8_SCHED; PG8_LDA(At, 0, 0); PG8_STAGE(PG8_SA(1, 1), a1 + hstep, voffA);
            PG8_WAIT_L(8); PG8_BAR; PG8_WAIT_L(0); PG8_MMA(0, 0, At, B0); PG8_BAR; PG8_SCHED;
            PG8_LDB(B1, 0, 1); PG8_STAGE(PG8_SB(0, 0), b2, voffB);
            PG8_BAR; PG8_WAIT_L(0); PG8_MMA(0, 1, At, B1); PG8_BAR;
            PG8_LDA(At, 0, 1); PG8_STAGE(PG8_SA(0, 0), a2, voffA);
            PG8_BAR; PG8_WAIT_L(0); PG8_MMA(1, 0, At, B0); PG8_BAR; PG8_SCHED;
            PG8_STAGE(PG8_SB(0, 1), b2 + hstep, voffB);
            PG8_WAIT_V(6); PG8_BAR; PG8_MMA(1, 1, At, B1); PG8_BAR;
            PG8_LDB(B0, 1, 0); PG8_SCHED; PG8_LDA(At, 1, 0); PG8_STAGE(PG8_SA(0, 1), a2 + hstep, voffA);
            PG8_WAIT_L(8); PG8_BAR; PG8_WAIT_L(0); PG8_MMA(0, 0, At, B0); PG8_BAR; PG8_SCHED;
            PG8_LDB(B1, 1, 1); PG8_STAGE(PG8_SB(1, 0), b3, voffB);
            PG8_BAR; PG8_WAIT_L(0); PG8_MMA(0, 1, At, B1); PG8_BAR;
            PG8_LDA(At, 1, 1); PG8_STAGE(PG8_SA(1, 0), a3, voffA);
            PG8_BAR; PG8_WAIT_L(0); PG8_MMA(1, 0, At, B0); PG8_BAR; PG8_SCHED;
            PG8_STAGE(PG8_SB(1, 1), b3 + hstep, voffB);
            PG8_WAIT_V(6); PG8_BAR; PG8_MMA(1, 1, At, B1); PG8_BAR;
            }
        }
        if constexpr (ALIGN_EPI) { if (wr == 0) PG8_BAR; }
        if constexpr (!Epi::AFTER_DRAIN) { E(acc, cur, wr, wc, fr, fq); S.done(cur); }
        if (!has_next) break;
#pragma unroll
        for (int a = 0; a < 2; ++a)
#pragma unroll
            for (int b = 0; b < 2; ++b)
#pragma unroll
                for (int m = 0; m < 4; ++m)
#pragma unroll
                    for (int n = 0; n < 2; ++n) acc[a][b][m][n] = (f32x4){0.f, 0.f, 0.f, 0.f};
        cur = nxt; cA = nA; cB = nB; ++ui;
        if constexpr (ALIGN_EPI) { if (wr == 1) PG8_BAR; }
    }
    PG8_WAIT_V(0);
    if constexpr (!ALIGN_EPI) { if (wr == 0) PG8_BAR; }
    PG8_BAR;
    if constexpr (Epi::AFTER_DRAIN) { E.fused(acc, cur, wr, wc, fr, fq, lds, wid, lane); S.done(cur); }
#undef PG8_SA
#undef PG8_SB
#undef PG8_STAGE
#undef PG8_LDA
#undef PG8_LDB
#undef PG8_MMA
#undef PG8_WAIT_V
#undef PG8_WAIT_L
#undef PG8_BAR
#undef PG8_SCHED
}
}

namespace pg8 {
typedef unsigned u32x2 __attribute__((ext_vector_type(2)));
constexpr float LOG2E = 1.4426950408889634f;
typedef float f32x2 __attribute__((ext_vector_type(2)));
__device__ __forceinline__ f32x2 gelu2(f32x2 x) {
    const f32x2 t = x * x;
    const f32x2 p = t * (-0.102943239f) + (-2.302208198f);
    const f32x2 a = x * p;
    f32x2 e; e.x = __builtin_amdgcn_exp2f(a.x); e.y = __builtin_amdgcn_exp2f(a.y);
    const f32x2 d = e + 1.0f;
    f32x2 r; r.x = __builtin_amdgcn_rcpf(d.x); r.y = __builtin_amdgcn_rcpf(d.y);
    return x * r;
}
__device__ __forceinline__ float gelu_tanh(float x) { const f32x2 r = gelu2((f32x2){x, x}); return r.x; }
__device__ __forceinline__ f32x4 gelu4(f32x4 v) { const f32x2 a = gelu2((f32x2){v[0], v[1]}), b = gelu2((f32x2){v[2], v[3]}); return (f32x4){a.x, a.y, b.x, b.y}; }
__device__ __forceinline__ float sigmoidf_(float x) { return __builtin_amdgcn_rcpf(1.0f + __builtin_amdgcn_exp2f(-LOG2E * x)); }
__device__ __forceinline__ u32x4 pack8(f32x4 v0, f32x4 v1) { u32x4 w; w.x = cvt_pk_bf16(v0[0], v0[1]); w.y = cvt_pk_bf16(v0[2], v0[3]); w.z = cvt_pk_bf16(v1[0], v1[1]); w.w = cvt_pk_bf16(v1[2], v1[3]); return w; }
__device__ __forceinline__ float dot4(f32x4 a) { return (a[0] * a[0] + a[1] * a[1]) + (a[2] * a[2] + a[3] * a[3]); }
__device__ __forceinline__ float rs_of(const float* ssq, int row) {
    return __builtin_amdgcn_rsqf(ssq[row] * (1.0f / 1024.0f) + 1e-6f);
}

struct EpiIn {
    static constexpr bool PERM = true, AFTER_DRAIN = false, PERMA = false;
    bf16_t* Z; const float* rstd;
    __device__ __forceinline__ void operator()(const f32x4 (&acc)[2][2][4][2], const Unit& u, int wr, int wc, int fr, int fq) const {
        const int row0 = u.pm * BM + wr * 64 + fr, col0 = u.pn * BM + wc * 32 + 8 * fq; const bool gel = u.pn >= 3;
        float rsv[2][4];
#pragma unroll
        for (int ai = 0; ai < 2; ++ai)
#pragma unroll
            for (int m = 0; m < 4; ++m) rsv[ai][m] = rstd[row0 + ai * HALF + m * 16];
#pragma unroll
        for (int ai = 0; ai < 2; ++ai)
#pragma unroll
            for (int m = 0; m < 4; ++m) { const int row = row0 + ai * HALF + m * 16; const float rs = rsv[ai][m]; bf16_t* rowp = Z + (size_t)row * 1792 + col0;
#pragma unroll
                for (int bj = 0; bj < 2; ++bj) { f32x4 v0 = acc[ai][bj][m][0] * rs, v1 = acc[ai][bj][m][1] * rs;
                    if (gel) { v0 = gelu4(v0); v1 = gelu4(v1); }
                    *(u32x4*)(rowp + bj * HALF) = pack8(v0, v1); } }
    }
};
struct EpiPlain {
    static constexpr bool PERM = true, AFTER_DRAIN = false, PERMA = false;
    bf16_t* O; int ldc;
    __device__ __forceinline__ void operator()(const f32x4 (&acc)[2][2][4][2], const Unit& u, int wr, int wc, int fr, int fq) const {
        const int row0 = u.pm * BM + wr * 64 + fr, col0 = u.pn * BM + wc * 32 + 8 * fq;
#pragma unroll
        for (int ai = 0; ai < 2; ++ai)
#pragma unroll
            for (int m = 0; m < 4; ++m) { bf16_t* rowp = O + (size_t)(row0 + ai * HALF + m * 16) * ldc + col0;
#pragma unroll
                for (int bj = 0; bj < 2; ++bj) *(u32x4*)(rowp + bj * HALF) = pack8(acc[ai][bj][m][0], acc[ai][bj][m][1]); }
    }
};
__device__ __forceinline__ void unpack8(u32x4 pw, f32x4& p0, f32x4& p1) {
    p0 = (f32x4){__uint_as_float(pw.x << 16), __uint_as_float(pw.x & 0xffff0000u), __uint_as_float(pw.y << 16), __uint_as_float(pw.y & 0xffff0000u)};
    p1 = (f32x4){__uint_as_float(pw.z << 16), __uint_as_float(pw.z & 0xffff0000u), __uint_as_float(pw.w << 16), __uint_as_float(pw.w & 0xffff0000u)};
}
template <bool BF, bool RS> struct EpiRes {
    static constexpr bool PERM = true, AFTER_DRAIN = false, PERMA = false;
    const void* base; bf16_t* outb; float* ssq; const float* rowscale;
    __device__ __forceinline__ void operator()(const f32x4 (&acc)[2][2][4][2], const Unit& u, int wr, int wc, int fr, int fq) const {
        const int row0 = u.pm * BM + wr * 64 + fr, col0 = u.pn * BM + wc * 32 + 8 * fq;
        f32x4 pf[4][2][2]; u32x4 pb[4][2];
#define ER_LOAD(ai_, m_) do { _Pragma("unroll") for (int bj = 0; bj < 2; ++bj) { const size_t off = (size_t)(row0 + (ai_) * HALF + (m_) * 16) * 1024 + col0 + bj * HALF; \
            if (BF) pb[m_][bj] = *(const u32x4*)((const bf16_t*)base + off); else { pf[m_][bj][0] = *(const f32x4*)((const float*)base + off); pf[m_][bj][1] = *(const f32x4*)((const float*)base + off + 4); } } } while (0)
        float rsc[2][4];
#pragma unroll
        for (int ai = 0; ai < 2; ++ai)
#pragma unroll
            for (int m = 0; m < 4; ++m) rsc[ai][m] = RS ? rowscale[row0 + ai * HALF + m * 16] : 1.0f;
#pragma unroll
        for (int m = 0; m < 4; ++m) ER_LOAD(0, m);
#pragma unroll
        for (int ai = 0; ai < 2; ++ai)
#pragma unroll
            for (int m = 0; m < 4; ++m) { const int row = row0 + ai * HALF + m * 16; float q = 0.f;
#pragma unroll
                for (int bj = 0; bj < 2; ++bj) { const size_t off = (size_t)row * 1024 + col0 + bj * HALF;
                    f32x4 b0, b1;
                    if (BF) unpack8(pb[m][bj], b0, b1); else { b0 = pf[m][bj][0]; b1 = pf[m][bj][1]; }
                    const f32x4 h0 = RS ? b0 + acc[ai][bj][m][0] * rsc[ai][m] : b0 + acc[ai][bj][m][0], h1 = RS ? b1 + acc[ai][bj][m][1] * rsc[ai][m] : b1 + acc[ai][bj][m][1];
                    *(u32x4*)(outb + off) = pack8(h0, h1);
                    q += dot4(h0) + dot4(h1); }
                if (ai == 0) ER_LOAD(1, m);
                q += __shfl_xor(q, 16); q += __shfl_xor(q, 32);
                if (fq == 0) (void)__hip_atomic_fetch_add(ssq + row, q, __ATOMIC_RELAXED, __HIP_MEMORY_SCOPE_AGENT); }
#undef ER_LOAD
    }
};
struct EpiPle {
    static constexpr bool PERM = true, AFTER_DRAIN = false, PERMA = false;
    const bf16_t* h2; const bf16_t* pp; float* out; const float* ssq_in; float* ssq_out; unsigned* cnt; const float* gfin;
    __device__ __forceinline__ void operator()(f32x4 (&acc)[2][2][4][2], const Unit& u, int wr, int wc, int fr, int fq) const {
        const int row0 = u.pm * BM + wr * 64 + fr, col0 = u.pn * BM + wc * 32 + 8 * fq;
        float rsv[2][4];
#pragma unroll
        for (int ai = 0; ai < 2; ++ai)
#pragma unroll
            for (int m = 0; m < 4; ++m) rsv[ai][m] = ssq_in[row0 + ai * HALF + m * 16];
        u32x4 ph[4][2], pq[4][2];
#define EP_LOAD(ai_, m_) do { _Pragma("unroll") for (int bj = 0; bj < 2; ++bj) { const size_t off = (size_t)(row0 + (ai_) * HALF + (m_) * 16) * 1024 + col0 + bj * HALF; \
            ph[m_][bj] = *(const u32x4*)(h2 + off); pq[m_][bj] = *(const u32x4*)(pp + off); } } while (0)
#pragma unroll
        for (int m = 0; m < 4; ++m) EP_LOAD(0, m);
#pragma unroll
        for (int ai = 0; ai < 2; ++ai)
#pragma unroll
            for (int m = 0; m < 4; ++m) { const int row = row0 + ai * HALF + m * 16; const float rs = __builtin_amdgcn_rsqf(rsv[ai][m] * (1.0f / 1024.0f) + 1e-6f); float q = 0.f;
#pragma unroll
                for (int bj = 0; bj < 2; ++bj) {
                    f32x4 b0, b1, p0, p1; unpack8(ph[m][bj], b0, b1); unpack8(pq[m][bj], p0, p1);
                    const f32x4 a0 = acc[ai][bj][m][0] * rs, a1 = acc[ai][bj][m][1] * rs;
                    f32x4 h0, h1;
#pragma unroll
                    for (int j = 0; j < 4; ++j) { h0[j] = b0[j] + p0[j] * sigmoidf_(a0[j]); h1[j] = b1[j] + p1[j] * sigmoidf_(a1[j]); }
                    acc[ai][bj][m][0] = h0; acc[ai][bj][m][1] = h1;
                    q += dot4(h0) + dot4(h1); }
                if (ai == 0) EP_LOAD(1, m);
                q += __shfl_xor(q, 16); q += __shfl_xor(q, 32);
                if (fq == 0) (void)__hip_atomic_fetch_add(ssq_out + row, q, __ATOMIC_RELAXED, __HIP_MEMORY_SCOPE_AGENT); }
#undef EP_LOAD
        asm volatile("s_waitcnt vmcnt(0)" ::: "memory");
        unsigned* pc = cnt + 64 * u.pm;
        if (fq == 0 && fr == 0) (void)__hip_atomic_fetch_add(pc, 1u, __ATOMIC_RELAXED, __HIP_MEMORY_SCOPE_AGENT);
        f32x4 gf[2][2];
#pragma unroll
        for (int bj = 0; bj < 2; ++bj) { gf[bj][0] = *(const f32x4*)(gfin + col0 + bj * HALF); gf[bj][1] = *(const f32x4*)(gfin + col0 + bj * HALF + 4); }
        { unsigned sp = 0u;
          while ((unsigned)__builtin_amdgcn_readfirstlane(__hip_atomic_load(pc, __ATOMIC_RELAXED, __HIP_MEMORY_SCOPE_AGENT)) < 32u) { __builtin_amdgcn_s_sleep(2); if (++sp > (1u << 16)) break; } }
        asm volatile("" ::: "memory");
#pragma unroll
        for (int ai = 0; ai < 2; ++ai)
#pragma unroll
            for (int m = 0; m < 4; ++m) { const int row = row0 + ai * HALF + m * 16;
                const float rs = __builtin_amdgcn_rsqf(__hip_atomic_load(ssq_out + row, __ATOMIC_RELAXED, __HIP_MEMORY_SCOPE_AGENT) * (1.0f / 1024.0f) + 1e-6f);
#pragma unroll
                for (int bj = 0; bj < 2; ++bj) { float* o = out + (size_t)row * 1024 + col0 + bj * HALF;
                    *(f32x4*)o = acc[ai][bj][m][0] * rs * gf[bj][0]; *(f32x4*)(o + 4) = acc[ai][bj][m][1] * rs * gf[bj][1]; } }
    }
};
struct EpiGlu {
    static constexpr bool PERM = true, AFTER_DRAIN = false, PERMA = true;
    bf16_t* act; const float* ssq_in; const float* conv_w; const float* conv_b; float* side;
    __device__ __forceinline__ void operator()(const f32x4 (&acc)[2][2][4][2], const Unit& u, int wr, int wc, int fr, int fq) const {
        const int ch0 = u.pn * 128 + wc * 32 + 8 * fq;
        f32x4 rq[2];
#pragma unroll
        for (int ai = 0; ai < 2; ++ai) rq[ai] = *(const f32x4*)(ssq_in + u.pm * BM + ai * HALF + wr * 64 + 4 * fr);
        f32x4 w0[2], w1[2], w2[2], cb[2];
#pragma unroll
        for (int n = 0; n < 2; ++n) { w0[n] = *(const f32x4*)(conv_w + ch0 + 4 * n); w1[n] = *(const f32x4*)(conv_w + 2816 + ch0 + 4 * n); w2[n] = *(const f32x4*)(conv_w + 5632 + ch0 + 4 * n); cb[n] = *(const f32x4*)(conv_b + ch0 + 4 * n); }
#pragma unroll
        for (int ai = 0; ai < 2; ++ai) {
            const int rowg = u.pm * BM + ai * HALF + wr * 64;
            const int grp = rowg >> 6;
            float rs[4];
#pragma unroll
            for (int m = 0; m < 4; ++m) rs[m] = __builtin_amdgcn_rsqf(rq[ai][m] * (1.0f / 1024.0f) + 1e-6f);
            u32x2 pk[4][2];
#pragma unroll
            for (int n = 0; n < 2; ++n) {
                f32x4 g[4], up0, dn3;
#pragma unroll
                for (int m = 0; m < 4; ++m) g[m] = acc[ai][0][m][n] * rs[m];
#pragma unroll
                for (int j = 0; j < 4; ++j) { up0[j] = __int_as_float(__builtin_amdgcn_update_dpp(0, __float_as_int(g[3][j]), 0x111, 0xf, 0xf, true));
                                              dn3[j] = __int_as_float(__builtin_amdgcn_update_dpp(0, __float_as_int(g[0][j]), 0x101, 0xf, 0xf, true)); }
#pragma unroll
                for (int m = 0; m < 4; ++m) {
                    const f32x4 up = m > 0 ? g[m > 0 ? m - 1 : 0] : up0, dn = m < 3 ? g[m < 3 ? m + 1 : 3] : dn3;
                    const f32x4 s = w1[n] * g[m] + w0[n] * up + w2[n] * dn + cb[n];
                    const f32x4 val = acc[ai][1][m][n] * rs[m];
                    const f32x4 a = gelu4(s) * val;
                    pk[m][n].x = cvt_pk_bf16(a[0], a[1]); pk[m][n].y = cvt_pk_bf16(a[2], a[3]);
                    if (m == 0) { if (fr == 0) { float* sp = side + (size_t)((grp * 2 + 0) * 3) * 2816 + ch0 + 4 * n; *(f32x4*)sp = s; *(f32x4*)(sp + 2816) = val; *(f32x4*)(sp + 5632) = g[m]; } }
                    if (m == 3) { if (fr == 15) { float* sp = side + (size_t)((grp * 2 + 1) * 3) * 2816 + ch0 + 4 * n; *(f32x4*)sp = s; *(f32x4*)(sp + 2816) = val; *(f32x4*)(sp + 5632) = g[m]; } }
                }
            }
#pragma unroll
            for (int m = 0; m < 4; ++m) { u32x4 w; w.x = pk[m][0].x; w.y = pk[m][0].y; w.z = pk[m][1].x; w.w = pk[m][1].y;
                *(u32x4*)(act + (size_t)(rowg + 4 * fr + m) * 2816 + ch0) = w; }
        }
    }
};
}

namespace pg8 {
struct BalancedOrder {
    StaticOrder so; int c;
    __host__ __device__ void init(int M, int N, int G_, int c_) { so.init(M, N, 1, 0); c = c_; }
    __host__ __device__ bool next(int i, Unit& u) const {
        int L;
        if (c < 128) { if (i >= 1) return false; L = c; } else { if (i >= 3) return false; L = 128 + (c - 128) * 3 + i; }
        return so.next(L, u);
    }
    __device__ __forceinline__ void a_ready(const Unit&) const {}
    __device__ __forceinline__ void done(const Unit&) const {}
};
}

#define LAS __attribute__((address_space(3)))
typedef unsigned short bf16;
typedef unsigned v4u __attribute__((ext_vector_type(4)));
typedef unsigned v2u __attribute__((ext_vector_type(2)));
typedef float f32x4 __attribute__((ext_vector_type(4)));
typedef short bf16x8 __attribute__((ext_vector_type(8)));
typedef short s16x4 __attribute__((ext_vector_type(4)));
#define LDS_WAIT() asm volatile("s_waitcnt lgkmcnt(0)" ::: "memory")
#define GAS __attribute__((address_space(1)))

constexpr int NWAVES = 8;
constexpr int SEQ = 2048, D = 1024, M = 16 * SEQ, INW = 1792, DFF = 2816, PLE = 256;
constexpr size_t MiB = 1u << 20;
constexpr size_t WS_WIN = 0, WS_WOUT = 4 * MiB, WS_WUP = 6 * MiB, WS_WDOWN = 17 * MiB, WS_WGATE = 23 * MiB, WS_WPROJ = 25 * MiB;
constexpr size_t WS_RSTD1 = 26 * MiB; constexpr size_t WS_SGUW = 27 * MiB;
constexpr size_t WS_PP = 40 * MiB;
constexpr size_t WS_XB = 104 * MiB;
constexpr size_t WS_MERGED = 296 * MiB;
constexpr size_t WS_SIDE = 104 * MiB;
constexpr size_t WS_H2B = 104 * MiB;
constexpr size_t WS_PB = 168 * MiB;
constexpr size_t WS_Z = 184 * MiB;
constexpr size_t WS_H1B = 184 * MiB;
constexpr size_t WS_H3B = 232 * MiB + 16 * MiB;
constexpr size_t WS_ACT = 296 * MiB;
constexpr size_t WS_END = 472 * MiB;
constexpr size_t WS_CTL = 33 * MiB;
constexpr size_t WS_CNT = WS_CTL + 16384;
constexpr size_t WS_SSQ1 = WS_CTL + 65536, WS_SSQ2 = WS_SSQ1 + 131072, WS_SSQ3 = WS_SSQ2 + 131072; constexpr size_t CTL_BYTES = 65536 + 3 * 131072;
constexpr int MISC_OFF = 147456 - 256;
constexpr int LDS_BYTES = 147456;

__device__ __forceinline__ unsigned f2bf(float f) { unsigned u = __builtin_bit_cast(unsigned, f); return (u + 0x7fffu + ((u >> 16) & 1u)) >> 16; }
__device__ __forceinline__ unsigned pk2(float lo, float hi) { return f2bf(lo) | (f2bf(hi) << 16); }
__device__ __forceinline__ float bf2f(unsigned short u) { return __uint_as_float((unsigned)u << 16); }
__device__ __forceinline__ float wave_sum(float v) {
#pragma unroll
    for (int o = 1; o < 64; o <<= 1) v += __shfl_xor(v, o);
    return v;
}

__device__ __forceinline__ void p0_transpose_item(const float* W, int K, int N, bf16* WT, const float* gk, bool upperm, LAS float* scr, int item, int lane) {
    const int nblk = N / 32, kb = item / nblk, nb = item % nblk, k0 = 64 * kb, n0 = 32 * nb;
    float wv[32];
#pragma unroll
    for (int i = 0; i < 32; ++i) wv[i] = W[(size_t)(k0 + 2 * i + (lane >> 5)) * N + n0 + (lane & 31)];
#pragma unroll
    for (int i = 0; i < 32; ++i) { const int kk = 2 * i + (lane >> 5); float w = wv[i]; if (gk) w *= gk[k0 + kk]; scr[kk * 33 + (lane & 31)] = w; }
    LDS_WAIT(); asm volatile("" ::: "memory");
    const int c = lane & 7;
#pragma unroll
    for (int j = 0; j < 4; ++j) { const int n = (lane >> 3) + 8 * j; const LAS float* s = scr + (8 * c) * 33 + n;
        v4u o; o.x = pk2(s[0 * 33], s[1 * 33]); o.y = pk2(s[2 * 33], s[3 * 33]); o.z = pk2(s[4 * 33], s[5 * 33]); o.w = pk2(s[6 * 33], s[7 * 33]);
        int nn = n0 + n;
        if (upperm) { const bool isv = nn >= DFF; const int ch = isv ? nn - DFF : nn; nn = (ch >> 7) * 256 + (isv ? 128 : 0) + (ch & 127); }
        *(v4u*)(WT + (size_t)nn * K + k0 + 8 * c) = o; }
    LDS_WAIT(); asm volatile("" ::: "memory");
}

#define XB_TMO      128
#define XB_XCNT(j)  (256  + 64 * (j))
#define XB_XSUB(j)  (1280 + 64 * (j))
#define XB_XGEN(j)  (2304 + 64 * (j))
#define XB_TOP      3328
#define XB_TOPGEN   3392
#define XCD_BAR_WORDS 3456
#define XB_SPIN_CAP (1u << 18)

__device__ __forceinline__ unsigned xb_ld(unsigned* p)              { return __hip_atomic_load(p, __ATOMIC_RELAXED, __HIP_MEMORY_SCOPE_AGENT); }
__device__ __forceinline__ unsigned xb_add(unsigned* p, unsigned v) { return __hip_atomic_fetch_add(p, v, __ATOMIC_RELAXED, __HIP_MEMORY_SCOPE_AGENT); }
__device__ __forceinline__ unsigned xb_xcc_id() { return (unsigned)__builtin_amdgcn_s_getreg((3 << 11) | 20) & 0xFu; }
#define XB_SPIN(cond, bar) do { unsigned _sp = 0; while (cond) { __builtin_amdgcn_s_sleep(1); \
    if ((++_sp & 255u) == 0u) { if (xb_ld(&(bar)[XB_TMO])) break; if (_sp > XB_SPIN_CAP) { atomicAdd(&(bar)[XB_TMO], 1u); break; } } } } while (0)

struct XcdBarrier {
    unsigned* bar; unsigned x;
    volatile LAS unsigned* st;
};

__device__ __forceinline__ XcdBarrier xcd_barrier_post(unsigned* bar, volatile LAS unsigned* st) {
    XcdBarrier b; b.bar = bar; b.x = xb_xcc_id(); b.st = st;
    if (threadIdx.x == 0) (void)xb_add(&bar[XB_XCNT(b.x)], 1u);
    return b;
}
__device__ __forceinline__ void xcd_barrier_complete(unsigned* bar, unsigned x, unsigned& nloc, unsigned& nx) {
    const unsigned G = gridDim.x * gridDim.y * gridDim.z;
    unsigned sum, cnt, mine, sp = 0u;
    for (;;) {
        sum = 0u; cnt = 0u; mine = 0u;
#pragma unroll
        for (unsigned j = 0; j < 16; ++j) { const unsigned c = xb_ld(&bar[XB_XCNT(j)]); sum += c; cnt += (c > 0u) ? 1u : 0u; mine = (j == x) ? c : mine; }
        if (sum == G) break;
        __builtin_amdgcn_s_sleep(1);
        if ((++sp & 255u) == 0u) { if (xb_ld(&bar[XB_TMO])) break; if (sp > XB_SPIN_CAP) { atomicAdd(&bar[XB_TMO], 1u); break; } }
    }
    nloc = mine > 0u ? mine : 1u; nx = cnt > 0u ? cnt : 1u;
}

__device__ __forceinline__ void xcd_barrier(const XcdBarrier& b) {
    asm volatile("s_waitcnt vmcnt(0)" ::: "memory");
    __syncthreads();
    if (threadIdx.x == 0) {
        unsigned* bar = b.bar;
        __builtin_amdgcn_s_waitcnt(0);
        unsigned nloc = b.st[0], nx = b.st[1];
        if (nloc == 0u) { xcd_barrier_complete(bar, b.x, nloc, nx); b.st[0] = nloc; b.st[1] = nx; }
        const unsigned old = xb_add(&bar[XB_XSUB(b.x)], 1u);
        const unsigned gen = old / nloc;
        if (old + 1u == (gen + 1u) * nloc) {
            __builtin_amdgcn_fence(__ATOMIC_RELEASE, "agent");
            asm volatile("s_waitcnt vmcnt(0)" ::: "memory");
            const unsigned og = xb_add(&bar[XB_TOP], 1u);
            const unsigned tg = og / nx;
            if (og + 1u == (tg + 1u) * nx) xb_add(&bar[XB_TOPGEN], 1u);
            else XB_SPIN(xb_ld(&bar[XB_TOPGEN]) == tg, bar);
            __builtin_amdgcn_fence(__ATOMIC_ACQUIRE, "agent");
            xb_add(&bar[XB_XGEN(b.x)], 1u);
            asm volatile("s_waitcnt vmcnt(0)" ::: "memory");
        } else {
            XB_SPIN(xb_ld(&bar[XB_XGEN(b.x)]) == gen, bar);
            __builtin_amdgcn_fence(__ATOMIC_ACQUIRE, "agent");
            asm volatile("s_waitcnt vmcnt(0)" ::: "memory");
        }
    }
    __syncthreads();
}

struct Args { const float* in[21]; float* out; unsigned char* ws; };

constexpr int KS_STRIDE = 144, VT_STRIDE = 1032, KS_OFF = 0, VT_OFF = 400 * 144;
__device__ __forceinline__ float attn_unit(LAS unsigned char* lds, const bf16* z, bf16* merged, const float* sink, int b, int qb, int tid, int wid, int lane) {
    const int i = lane & 15, g = lane >> 4;
    const size_t zrow0 = (size_t)b * SEQ;
    const int kpos0 = 128 * (qb - 1);
    const size_t qrow = zrow0 + 128 * qb + 16 * wid + i;
    float ssq = 0.f;
    const float sinkv = sink[lane & 7];
    v4u kreg[6];
#define ATT_ISSUE_K(kvh_) do { \
        _Pragma("unroll") for (int e_ = 0; e_ < 6; ++e_) { const int c = tid + 512 * e_; const int key = c >> 3, dch = c & 7; const int pos = kpos0 + key; kreg[e_] = (v4u){0u, 0u, 0u, 0u}; \
            if ((unsigned)pos < (unsigned)SEQ) kreg[e_] = *(const v4u*)(z + (zrow0 + pos) * INW + 512 + 64 * (kvh_) + 8 * dch); } } while (0)
#define ATT_ISSUE_V(kvh_) do { \
        _Pragma("unroll") for (int e_ = 0; e_ < 3; ++e_) { const int c = tid + 512 * e_; const int dch = c / 192, kp = c % 192; const int pos = kpos0 + 2 * kp; vra[e_] = (v4u){0u, 0u, 0u, 0u}; vrb[e_] = (v4u){0u, 0u, 0u, 0u}; \
            if ((unsigned)pos < (unsigned)SEQ) { const bf16* src = z + (zrow0 + pos) * INW + 640 + 64 * (kvh_) + 8 * dch; vra[e_] = *(const v4u*)src; vrb[e_] = *(const v4u*)(src + INW); } } } while (0)
#define ATT_WRITE() do { \
        _Pragma("unroll") for (int e_ = 0; e_ < 6; ++e_) { const int c = tid + 512 * e_; const int key = c >> 3, dch = c & 7; *(LAS v4u*)(lds + KS_OFF + key * KS_STRIDE + dch * 16) = kreg[e_]; } \
        _Pragma("unroll") for (int e_ = 0; e_ < 3; ++e_) { const int c = tid + 512 * e_; const int dch = c / 192, kp = c % 192; LAS unsigned char* dst = lds + VT_OFF + (8 * dch) * VT_STRIDE + kp * 4; \
            _Pragma("unroll") for (int e = 0; e < 4; ++e) { const unsigned a = vra[e_][e], bb = vrb[e_][e]; \
                *(LAS unsigned*)(dst + (2 * e) * VT_STRIDE) = (a & 0xffffu) | (bb << 16); \
                *(LAS unsigned*)(dst + (2 * e + 1) * VT_STRIDE) = (a >> 16) | (bb & 0xffff0000u); } } } while (0)
    ATT_ISSUE_K(0);
    bf16x8 qn0 = *(const bf16x8*)(z + qrow * INW + 8 * g), qn1 = *(const bf16x8*)(z + qrow * INW + 32 + 8 * g);
    for (int c = tid; c < 64 * 12; c += 512) { const int d = c / 12, k = c % 12; *(LAS unsigned*)(lds + VT_OFF + d * VT_STRIDE + 768 + k * 4) = 0u; }
#pragma unroll 1
    for (int kvh = 0; kvh < 2; ++kvh) {
        { v4u vra[3], vrb[3]; ATT_ISSUE_V(kvh);
        __syncthreads();
        ATT_WRITE(); }
        __syncthreads();
        if (kvh == 0) ATT_ISSUE_K(1);
#pragma unroll 1
        for (int hh = 0; hh < 4; ++hh) {
            const int h = kvh * 4 + hh;
            const bf16x8 qf0 = qn0, qf1 = qn1;
            { const int hn = (h + 1) & 7; qn0 = *(const bf16x8*)(z + qrow * INW + 64 * hn + 8 * g); qn1 = *(const bf16x8*)(z + qrow * INW + 64 * hn + 32 + 8 * g); }
            const float slope2 = __builtin_amdgcn_exp2f(-(float)(h + 1)) * pg8::LOG2E;
            const float sink2 = __int_as_float(__builtin_amdgcn_readlane(__float_as_int(sinkv), h)) * pg8::LOG2E;
            int iv = i - 4 * g, pv = kpos0 + 16 * wid + 4 * g; asm volatile("" : "+v"(iv), "+v"(pv));
            f32x4 s[17];
#pragma unroll
            for (int j = 0; j < 17; ++j) {
                const LAS unsigned char* kp = lds + KS_OFF + (16 * (wid + j) + i) * KS_STRIDE + g * 16;
                const bf16x8 k0 = *(const LAS bf16x8*)kp, k1 = *(const LAS bf16x8*)(kp + 64);
                f32x4 a = (f32x4){0.f, 0.f, 0.f, 0.f};
                a = __builtin_amdgcn_mfma_f32_16x16x32_bf16(k0, qf0, a, 0, 0, 0);
                a = __builtin_amdgcn_mfma_f32_16x16x32_bf16(k1, qf1, a, 0, 0, 0);
                s[j] = a;
                if ((j & 7) == 7) __builtin_amdgcn_sched_barrier(0);
            }
            __builtin_amdgcn_sched_barrier(0);
            float mraw = s[0][0];
#pragma unroll
            for (int j = 0; j < 17; ++j)
#pragma unroll
                for (int r = 0; r < 4; ++r) mraw = fmaxf(mraw, s[j][r]);
            mraw = fmaxf(mraw, __shfl_xor(mraw, 16)); mraw = fmaxf(mraw, __shfl_xor(mraw, 32));
            const float mx = fmaxf(mraw * (0.125f * pg8::LOG2E), sink2);
            const float fiv = (float)iv;
            const float baseN = -__builtin_fmaf(slope2, fiv, mx);
            const float baseP = __builtin_fmaf(slope2, fiv, -mx);
#pragma unroll
            for (int j = 0; j < 17; ++j)
#pragma unroll
                for (int r = 0; r < 4; ++r) { const float c = (float)(16 * j + r - 128); float bias;
                    if (j <= 7) bias = __builtin_fmaf(slope2, c, baseN); else if (j >= 9) bias = __builtin_fmaf(-slope2, c, baseP); else bias = -__builtin_fmaf(__builtin_fabsf(c - fiv), slope2, mx);
                    float e = __builtin_amdgcn_exp2f(__builtin_fmaf(s[j][r], 0.125f * pg8::LOG2E, bias));
                    if (j == 0 || j == 16) e = (__builtin_fabsf(c - fiv) <= 128.f) ? e : 0.f;
                    s[j][r] = e; }
            if (qb == 0 || qb == 15) {
                asm volatile("" ::: "memory");
#pragma unroll
                for (int j = 0; j < 17; ++j)
#pragma unroll
                    for (int r = 0; r < 4; ++r) { const int pos = pv + 16 * j + r; s[j][r] = ((unsigned)pos < (unsigned)SEQ) ? s[j][r] : 0.f; }
            }
            float sum = 0.f;
#pragma unroll
            for (int j = 0; j < 17; ++j) sum += (s[j][0] + s[j][1]) + (s[j][2] + s[j][3]);
            sum += __shfl_xor(sum, 16); sum += __shfl_xor(sum, 32);
            const float inv = __builtin_amdgcn_rcpf(sum + __builtin_amdgcn_exp2f(sink2 - mx));
            f32x4 o[4];
#pragma unroll
            for (int dt = 0; dt < 4; ++dt) o[dt] = (f32x4){0.f, 0.f, 0.f, 0.f};
#pragma unroll
            for (int sl = 0; sl < 9; ++sl) {
                v4u pw; pw.x = pg8::cvt_pk_bf16(s[2 * sl][0], s[2 * sl][1]); pw.y = pg8::cvt_pk_bf16(s[2 * sl][2], s[2 * sl][3]);
                if (sl < 8) { pw.z = pg8::cvt_pk_bf16(s[(2 * sl + 1) & 15][0], s[(2 * sl + 1) & 15][1]); pw.w = pg8::cvt_pk_bf16(s[(2 * sl + 1) & 15][2], s[(2 * sl + 1) & 15][3]); }
                else { pw.z = 0u; pw.w = 0u; }
                const bf16x8 pf = __builtin_bit_cast(bf16x8, pw);
#pragma unroll
                for (int dt = 0; dt < 4; ++dt) {
                    const LAS unsigned char* vp = lds + VT_OFF + (16 * dt + i) * VT_STRIDE + (16 * (wid + 2 * sl) + 4 * g) * 2;
                    const v2u lo = *(const LAS v2u*)vp, hi = *(const LAS v2u*)(vp + 32);
                    const v4u vw = (v4u){lo.x, lo.y, hi.x, hi.y};
                    o[dt] = __builtin_amdgcn_mfma_f32_16x16x32_bf16(__builtin_bit_cast(bf16x8, vw), pf, o[dt], 0, 0, 0);
                }
                if (sl & 1) __builtin_amdgcn_sched_barrier(0);
            }
            __builtin_amdgcn_sched_barrier(0);
#pragma unroll
            for (int dt = 0; dt < 4; ++dt) { o[dt] = o[dt] * inv; ssq += pg8::dot4(o[dt]);
                v2u w; w.x = pg8::cvt_pk_bf16(o[dt][0], o[dt][1]); w.y = pg8::cvt_pk_bf16(o[dt][2], o[dt][3]);
                *(v2u*)(merged + qrow * 1024 + 64 * h + 16 * dt + 4 * g) = w; }
        }
    }
#undef ATT_ISSUE_K
#undef ATT_ISSUE_V
#undef ATT_WRITE
    ssq += __shfl_xor(ssq, 16); ssq += __shfl_xor(ssq, 32);
    return ssq;
}

constexpr int VV_STRIDE = 272;
__device__ __forceinline__ void sgu_unit(LAS unsigned char* lds, const bf16* z, bf16* merged, const float* ln_g, const float* ln_b, const bf16* sw, const float* sb, float ssq_a, float* rsa, int b, int ck, int tid, int wid, int lane) {
    const int i = lane & 15, g = lane >> 4;
    const size_t R0 = (size_t)b * SEQ + 128 * ck;
    const size_t orow = R0 + 16 * wid + i;
    bf16x8 wfA[4][4];
#define SGU_WLOAD4(dst, h0_) do { _Pragma("unroll") for (int hh_ = 0; hh_ < 4; ++hh_) { const bf16* wrow_ = sw + ((size_t)((h0_) + hh_) * 128 + 16 * wid + i) * 128 + 8 * g; \
        _Pragma("unroll") for (int ks = 0; ks < 4; ++ks) dst[hh_][ks] = *(const bf16x8*)(wrow_ + 32 * ks); } } while (0)
#define SGU_WLOAD1(dst, h_) do { const bf16* wrow_ = sw + ((size_t)(h_) * 128 + 16 * wid + i) * 128 + 8 * g; \
        _Pragma("unroll") for (int ks = 0; ks < 4; ++ks) dst[ks] = *(const bf16x8*)(wrow_ + 32 * ks); } while (0)
    SGU_WLOAD1(wfA[0], 0); SGU_WLOAD1(wfA[1], 1);
    v2u uw[8][4]; float biasv[8];
#pragma unroll
    for (int h = 0; h < 8; ++h) biasv[h] = sb[h * 128 + 16 * wid + i];
#pragma unroll
    for (int h = 0; h < 4; ++h)
#pragma unroll
        for (int ct = 0; ct < 4; ++ct) uw[h][ct] = *(const v2u*)(z + orow * INW + 768 + 64 * h + 16 * ct + 4 * g);
    __syncthreads();
    {
        float lg[8], lb[8];
#pragma unroll
        for (int e = 0; e < 8; ++e) { lg[e] = ln_g[lane + 64 * e]; lb[e] = ln_b[lane + 64 * e]; }
        unsigned short xr[4][8];
        const bf16* rbase = z + (R0 + 16 * wid) * INW + 1280 + lane;
#pragma unroll
        for (int rr = 0; rr < 4; ++rr)
#pragma unroll
            for (int e = 0; e < 8; ++e) xr[rr][e] = rbase[(size_t)rr * INW + 64 * e];
#pragma unroll 1
        for (int it = 0; it < 4; ++it) { const int s = 16 * wid + 4 * it;
            float x[4][8], sm[4], sq[4];
#pragma unroll
            for (int rr = 0; rr < 4; ++rr)
#pragma unroll
                for (int e = 0; e < 8; ++e) x[rr][e] = bf2f(xr[rr][e]);
            { const int itn = (it + 1) & 3;
#pragma unroll
              for (int rr = 0; rr < 4; ++rr)
#pragma unroll
                for (int e = 0; e < 8; ++e) xr[rr][e] = rbase[(size_t)(4 * itn + rr) * INW + 64 * e]; }
#pragma unroll
            for (int rr = 0; rr < 4; ++rr) { sm[rr] = 0.f; sq[rr] = 0.f;
#pragma unroll
                for (int e = 0; e < 8; ++e) { sm[rr] += x[rr][e]; sq[rr] += x[rr][e] * x[rr][e]; } }
#pragma unroll
            for (int o = 1; o < 64; o <<= 1)
#pragma unroll
                for (int rr = 0; rr < 4; ++rr) { sm[rr] += __shfl_xor(sm[rr], o); sq[rr] += __shfl_xor(sq[rr], o); }
            float mean[4], rsd[4];
#pragma unroll
            for (int rr = 0; rr < 4; ++rr) { mean[rr] = sm[rr] * (1.0f / 512.0f); const float var = fmaxf(sq[rr] * (1.0f / 512.0f) - mean[rr] * mean[rr], 0.f); rsd[rr] = __builtin_amdgcn_rsqf(var + 1e-5f); }
#pragma unroll
            for (int e = 0; e < 8; ++e) {
                const float y0 = (x[0][e] - mean[0]) * rsd[0] * lg[e] + lb[e], y1 = (x[1][e] - mean[1]) * rsd[1] * lg[e] + lb[e];
                const float y2 = (x[2][e] - mean[2]) * rsd[2] * lg[e] + lb[e], y3 = (x[3][e] - mean[3]) * rsd[3] * lg[e] + lb[e];
                v2u w; w.x = pg8::cvt_pk_bf16(y0, y1); w.y = pg8::cvt_pk_bf16(y2, y3);
                *(LAS v2u*)(lds + (lane + 64 * e) * VV_STRIDE + s * 2) = w; }
        }
    }
    SGU_WLOAD1(wfA[2], 2); SGU_WLOAD1(wfA[3], 3);
#pragma unroll
    for (int h = 4; h < 8; ++h)
#pragma unroll
        for (int ct = 0; ct < 4; ++ct) uw[h][ct] = *(const v2u*)(z + orow * INW + 768 + 64 * h + 16 * ct + 4 * g);
    __syncthreads();
    float ssq = 0.f;
    v2u opk[8][4];
#define SGU_GROUP(h_, wfx_, HU_) do { \
        const float bias = biasv[HU_]; \
        _Pragma("unroll") for (int ct = 0; ct < 4; ++ct) { \
            f32x4 acc = (f32x4){0.f, 0.f, 0.f, 0.f}; \
            _Pragma("unroll") for (int ks = 0; ks < 4; ++ks) { \
                const LAS unsigned char* vp = lds + (64 * (h_) + 16 * ct + i) * VV_STRIDE + (32 * ks + 8 * g) * 2; \
                acc = __builtin_amdgcn_mfma_f32_16x16x32_bf16(*(const LAS bf16x8*)vp, wfx_[ks], acc, 0, 0, 0); } \
            const int col = 64 * (h_) + 16 * ct + 4 * g; const v2u uu = uw[HU_][ct]; \
            f32x4 o; o[0] = __uint_as_float(uu.x << 16) * (acc[0] + bias); o[1] = __uint_as_float(uu.x & 0xffff0000u) * (acc[1] + bias); \
            o[2] = __uint_as_float(uu.y << 16) * (acc[2] + bias); o[3] = __uint_as_float(uu.y & 0xffff0000u) * (acc[3] + bias); \
            ssq += pg8::dot4(o); \
            v2u w; w.x = pg8::cvt_pk_bf16(o[0], o[1]); w.y = pg8::cvt_pk_bf16(o[2], o[3]); opk[HU_][ct] = w; (void)col; } \
        if ((h_) < 4) SGU_WLOAD1(wfx_, (h_) + 4); } while (0)
    SGU_GROUP(0, wfA[0], 0); SGU_GROUP(1, wfA[1], 1); SGU_GROUP(2, wfA[2], 2); SGU_GROUP(3, wfA[3], 3);
    SGU_GROUP(4, wfA[0], 4); SGU_GROUP(5, wfA[1], 5); SGU_GROUP(6, wfA[2], 6); SGU_GROUP(7, wfA[3], 7);
#undef SGU_GROUP
#undef SGU_WLOAD4
#undef SGU_WLOAD1
    ssq += __shfl_xor(ssq, 16); ssq += __shfl_xor(ssq, 32);
    const float ms_a = ssq_a * (1.0f / 512.0f) + 1e-6f;
    if (g == 0) rsa[orow] = __builtin_amdgcn_rsqf(ms_a);
    const float rs = __builtin_amdgcn_rsqf(ssq * (1.0f / 512.0f) + 1e-6f) * __builtin_amdgcn_sqrtf(ms_a);
#pragma unroll
    for (int h = 0; h < 8; ++h)
#pragma unroll
        for (int ct = 0; ct < 4; ++ct) { const v2u w = opk[h][ct];
            v2u o; o.x = pg8::cvt_pk_bf16(__uint_as_float(w.x << 16) * rs, __uint_as_float(w.x & 0xffff0000u) * rs); o.y = pg8::cvt_pk_bf16(__uint_as_float(w.y << 16) * rs, __uint_as_float(w.y & 0xffff0000u) * rs);
            *(v2u*)(merged + orow * 1024 + 512 + 64 * h + 16 * ct + 4 * g) = o; }
    __syncthreads();
}

typedef const char __attribute__((address_space(4)))* kaptr_t;
#define KA_IN(k) (*(const float* const __attribute__((address_space(4)))*)(ka + 8 * (k)))
#define KA_OUT   (*(float* const __attribute__((address_space(4)))*)(ka + 8 * 21))
#define KA_WS    (*(unsigned char* const __attribute__((address_space(4)))*)(ka + 8 * 22))
#define KA_FENCE() asm volatile("" : "+s"(ka))
#ifndef P4_WGM
#define P4_WGM 4
#endif
#ifndef SEAM
#define SEAM() xcd_barrier(bar)
#endif
__global__ void __launch_bounds__(NWAVES * 64, 2) hymba_fwd(Args args) {
    extern __shared__ __attribute__((aligned(16))) unsigned char lds_[];
    LAS unsigned char* lds = (LAS unsigned char*)lds_;
    kaptr_t ka = (kaptr_t)__builtin_amdgcn_kernarg_segment_ptr();
    const int tid = threadIdx.x, lane = tid & 63, wid = __builtin_amdgcn_readfirstlane(tid >> 6);
    const int G = gridDim.x, bx = blockIdx.x;
    const int gw = bx * NWAVES + wid, NGW = G * NWAVES;
    volatile LAS unsigned* MISC = (volatile LAS unsigned*)(lds + MISC_OFF);
    if (tid < 32) MISC[tid] = 0u;
    __syncthreads();
    XcdBarrier bar = xcd_barrier_post((unsigned*)(KA_WS + WS_CTL), MISC + 8);
    if (G == 0x7fffffff) cg::this_grid().sync();

#ifndef SKIP_P0
    {
        KA_FENCE(); unsigned char* ws = KA_WS;
        LAS float* scr = (LAS float*)(lds + wid * 16384);
        constexpr int I_IN = 16 * 56, I_OUT = 16 * 32, I_UP = 16 * 176, I_DOWN = 44 * 32, I_GATE = 16 * 32, I_PROJ = 4 * 32;
        constexpr int NITEMS = I_IN + I_OUT + I_UP + I_DOWN + I_GATE + I_PROJ;
        for (int it = gw; it < NITEMS; it += NGW) {
            int r = it;
            if (r < I_IN) { p0_transpose_item(KA_IN(3), D, INW, (bf16*)(ws + WS_WIN), KA_IN(2), false, scr, r, lane); continue; } r -= I_IN;
            if (r < I_OUT) { const int kb = r / 32; p0_transpose_item(KA_IN(11), D, D, (bf16*)(ws + WS_WOUT), kb < 8 ? KA_IN(9) : KA_IN(10) - 512, false, scr, r, lane); continue; } r -= I_OUT;
            if (r < I_UP) { p0_transpose_item(KA_IN(13), D, 2 * DFF, (bf16*)(ws + WS_WUP), KA_IN(12), true, scr, r, lane); continue; } r -= I_UP;
            if (r < I_DOWN) { p0_transpose_item(KA_IN(16), DFF, D, (bf16*)(ws + WS_WDOWN), nullptr, false, scr, r, lane); continue; } r -= I_DOWN;
            if (r < I_GATE) { p0_transpose_item(KA_IN(18), D, D, (bf16*)(ws + WS_WGATE), KA_IN(17), false, scr, r, lane); continue; } r -= I_GATE;
            p0_transpose_item(KA_IN(19), PLE, D, (bf16*)(ws + WS_WPROJ), nullptr, false, scr, r, lane);
        }
        { const float* sgw = KA_IN(7); bf16* SW = (bf16*)(ws + WS_SGUW);
          for (int idx = gw * 64 + lane; idx < 8 * 128 * 128 / 4; idx += NGW * 64) { const f32x4 v = *((const f32x4*)sgw + idx); v2u w; w.x = pg8::cvt_pk_bf16(v[0], v[1]); w.y = pg8::cvt_pk_bf16(v[2], v[3]); *((v2u*)SW + idx) = w; } }
        const float* x = KA_IN(0); const float* pin = KA_IN(1); float* rstd1 = (float*)(ws + WS_RSTD1); bf16* XB = (bf16*)(ws + WS_XB); bf16* PB = (bf16*)(ws + WS_PB);
        f32x4 v[2][4], pv[2], vn[2][4], pvn[2];
#define P0_LOAD(dst, pdst, m0_) do { _Pragma("unroll") for (int t = 0; t < 2; ++t) { const int m = (m0_) + t * NGW; const f32x4* xr = (const f32x4*)(x + (size_t)m * D) + lane; \
            _Pragma("unroll") for (int j = 0; j < 4; ++j) dst[t][j] = xr[64 * j]; \
            pdst[t] = *((const f32x4*)(pin + (size_t)m * PLE) + lane); } } while (0)
        P0_LOAD(vn, pvn, gw);
#pragma unroll 1
        for (int m0 = gw; m0 < M; m0 += 2 * NGW) {
            float s[2];
#pragma unroll
            for (int t = 0; t < 2; ++t) { pv[t] = pvn[t];
#pragma unroll
                for (int j = 0; j < 4; ++j) v[t][j] = vn[t][j]; }
            { const int mn = (m0 + 2 * NGW < M) ? m0 + 2 * NGW : gw; P0_LOAD(vn, pvn, mn); }
#pragma unroll
            for (int t = 0; t < 2; ++t) { s[t] = 0.f;
#pragma unroll
                for (int j = 0; j < 4; ++j) s[t] += pg8::dot4(v[t][j]); }
#pragma unroll
            for (int o = 1; o < 64; o <<= 1) { s[0] += __shfl_xor(s[0], o); s[1] += __shfl_xor(s[1], o); }
#pragma unroll
            for (int t = 0; t < 2; ++t) { const int m = m0 + t * NGW;
                if (lane == 0) rstd1[m] = __builtin_amdgcn_rsqf(s[t] * (1.0f / 1024.0f) + 1e-6f);
                v2u* o8 = (v2u*)(XB + (size_t)m * D) + lane;
#pragma unroll
                for (int j = 0; j < 4; ++j) { v2u w; w.x = pg8::cvt_pk_bf16(v[t][j][0], v[t][j][1]); w.y = pg8::cvt_pk_bf16(v[t][j][2], v[t][j][3]); o8[64 * j] = w; }
                v2u w; w.x = pg8::cvt_pk_bf16(pv[t][0], pv[t][1]); w.y = pg8::cvt_pk_bf16(pv[t][2], pv[t][3]); *((v2u*)(PB + (size_t)m * PLE) + lane) = w; }
        }
#undef P0_LOAD
    }
#endif
    SEAM();

#ifndef SKIP_P1
#ifndef SKIP_P1A
    {
        KA_FENCE(); unsigned char* ws = KA_WS;
        pg8::Gemm g{(bf16*)(ws + WS_XB), (bf16*)(ws + WS_WIN), M, INW, D}; pg8::StaticOrder S; S.init(M, INW, G, bx);
        pg8::EpiIn E{(bf16*)(ws + WS_Z), (const float*)(ws + WS_RSTD1)};
        pg8::gemm_phase<pg8::EpiIn, pg8::StaticOrder, true, true>(lds, g, S, E);
    }
#endif
#ifndef SKIP_P1B
    {
        KA_FENCE(); unsigned char* ws = KA_WS;
        int kp = PLE; asm volatile("" : "+s"(kp));
        pg8::Gemm g{(bf16*)(ws + WS_PB), (bf16*)(ws + WS_WPROJ), M, D, kp}; pg8::BalancedOrder S; S.init(M, D, G, bx);
        pg8::EpiPlain E{(bf16*)(ws + WS_PP), D};
        pg8::gemm_phase<pg8::EpiPlain, pg8::BalancedOrder, true, true>(lds, g, S, E);
    }
#endif
#endif
    SEAM();

#ifndef SKIP_P2
    {
#pragma unroll 1
        for (int u = bx; u < 256; u += G) {
            float ssq_a;
            { KA_FENCE(); unsigned char* ws = KA_WS;
              ssq_a = attn_unit(lds, (const bf16*)(ws + WS_Z), (bf16*)(ws + WS_MERGED), KA_IN(4), u >> 4, u & 15, tid, wid, lane); }
            asm volatile("" : "+v"(ssq_a) :: "memory");
            { KA_FENCE(); unsigned char* ws = KA_WS; int tid2 = tid; asm volatile("" : "+v"(tid2));
              const int lane2 = tid2 & 63, wid2 = __builtin_amdgcn_readfirstlane(tid2 >> 6);
              sgu_unit(lds, (const bf16*)(ws + WS_Z), (bf16*)(ws + WS_MERGED), KA_IN(5), KA_IN(6), (const bf16*)(ws + WS_SGUW), KA_IN(8), ssq_a, (float*)(ws + WS_RSTD1), u >> 4, u & 15, tid2, wid2, lane2); }
        }
    }
#endif
    SEAM();

#ifndef SKIP_P3
    {
        KA_FENCE(); unsigned char* ws = KA_WS;
        pg8::Gemm g{(bf16*)(ws + WS_MERGED), (bf16*)(ws + WS_WOUT), M, D, D}; pg8::StaticOrder S; S.init(M, D, G, bx);
        pg8::EpiRes<true, true> E{(const bf16*)(ws + WS_XB), (bf16*)(ws + WS_H1B), (float*)(ws + WS_SSQ1), (const float*)(ws + WS_RSTD1)};
        pg8::gemm_phase<pg8::EpiRes<true, true>, pg8::StaticOrder, true, true>(lds, g, S, E);
    }
#endif
    SEAM();

#ifndef SKIP_P4
    {
        KA_FENCE(); unsigned char* ws = KA_WS;
        pg8::Gemm g{(bf16*)(ws + WS_H1B), (bf16*)(ws + WS_WUP), M, 2 * DFF, D}; pg8::StaticOrder S; S.init(M, 2 * DFF, G, bx, P4_WGM);
        pg8::EpiGlu E{(bf16*)(ws + WS_ACT), (const float*)(ws + WS_SSQ1), KA_IN(14), KA_IN(15), (float*)(ws + WS_SIDE)};
        pg8::gemm_phase<pg8::EpiGlu, pg8::StaticOrder, true, true>(lds, g, S, E);
    }
#endif
    SEAM();

#ifndef SKIP_P4B
    {
        KA_FENCE(); unsigned char* ws = KA_WS;
        const float* conv_w = KA_IN(14); const float* SIDE = (const float*)(ws + WS_SIDE); bf16* ACT = (bf16*)(ws + WS_ACT);
        const int nth = G * 512;
        for (int idx = bx * 512 + tid; idx < 512 * 2 * 704; idx += nth) {
            const int q = idx % 704, gwh = idx / 704, which = gwh & 1, grp = gwh >> 1, ch = 4 * q;
            const int row = 64 * grp + (which ? 63 : 0);
            const f32x4 sp = *(const f32x4*)(SIDE + (size_t)(gwh * 3 + 0) * DFF + ch), vl = *(const f32x4*)(SIDE + (size_t)(gwh * 3 + 1) * DFF + ch);
            f32x4 ext = (f32x4){0.f, 0.f, 0.f, 0.f};
            if (which) { if (((row + 1) & (SEQ - 1)) != 0) ext = *(const f32x4*)(SIDE + (size_t)(((grp + 1) * 2 + 0) * 3 + 2) * DFF + ch); }
            else       { if ((row & (SEQ - 1)) != 0)       ext = *(const f32x4*)(SIDE + (size_t)(((grp - 1) * 2 + 1) * 3 + 2) * DFF + ch); }
            const f32x4 w = *(const f32x4*)(conv_w + (which ? 2 * DFF : 0) + ch);
            const f32x4 a = pg8::gelu4(sp + w * ext) * vl;
            v2u o; o.x = pg8::cvt_pk_bf16(a[0], a[1]); o.y = pg8::cvt_pk_bf16(a[2], a[3]);
            *(v2u*)(ACT + (size_t)row * DFF + ch) = o;
        }
    }
#endif
    SEAM();

#ifndef SKIP_P5
    {
        KA_FENCE(); unsigned char* ws = KA_WS;
        pg8::Gemm g{(bf16*)(ws + WS_ACT), (bf16*)(ws + WS_WDOWN), M, D, DFF}; pg8::StaticOrder S; S.init(M, D, G, bx);
        pg8::EpiRes<true, false> E{(const bf16*)(ws + WS_H1B), (bf16*)(ws + WS_H2B), (float*)(ws + WS_SSQ2), nullptr};
        pg8::gemm_phase<pg8::EpiRes<true, false>, pg8::StaticOrder, true, true>(lds, g, S, E);
    }
#endif
    SEAM();

#ifndef SKIP_P6
    {
        KA_FENCE(); unsigned char* ws = KA_WS;
        pg8::Gemm g{(bf16*)(ws + WS_H2B), (bf16*)(ws + WS_WGATE), M, D, D}; pg8::StaticOrder S; S.init(M, D, G, bx);
        pg8::EpiPle E{(const bf16*)(ws + WS_H2B), (const bf16*)(ws + WS_PP), KA_OUT, (const float*)(ws + WS_SSQ2), (float*)(ws + WS_SSQ3), (unsigned*)(ws + WS_CNT), KA_IN(20)};
        pg8::gemm_phase<pg8::EpiPle, pg8::StaticOrder, true, true>(lds, g, S, E);
    }
#endif
}

extern "C" void kernel_launch(void* const* d_in, const int* in_sizes, int n_in, void* d_out, int out_size, void* d_ws, size_t ws_size, hipStream_t stream) {
    static int grid = 0;
    if (grid == 0) {
        if (n_in != 21 || in_sizes[0] != M * D || out_size != M * D || ws_size < WS_END) { fprintf(stderr, "kernel_launch: unexpected shapes / workspace (n_in %d, in0 %d, out %d, ws %zu)\n", n_in, n_in > 0 ? in_sizes[0] : -1, out_size, ws_size); grid = -1; return; }
        int dev = 0, cus = 0, per_cu = 0;
        if (hipGetDevice(&dev) != hipSuccess || hipDeviceGetAttribute(&cus, hipDeviceAttributeMultiprocessorCount, dev) != hipSuccess) { grid = -1; return; }
        if (hipFuncSetAttribute((const void*)hymba_fwd, hipFuncAttributeMaxDynamicSharedMemorySize, LDS_BYTES) != hipSuccess) { fprintf(stderr, "kernel_launch: hipFuncSetAttribute failed\n"); grid = -1; return; }
        if (hipOccupancyMaxActiveBlocksPerMultiprocessor(&per_cu, (const void*)hymba_fwd, NWAVES * 64, LDS_BYTES) != hipSuccess || per_cu < 1) { fprintf(stderr, "kernel_launch: occupancy query failed (%d)\n", per_cu); (void)hipGetLastError(); grid = -1; return; }
        grid = cus;
    }
    if (grid < 0) return;
    (void)hipMemsetAsync((unsigned char*)d_ws + WS_CTL, 0, CTL_BYTES, stream);
    Args a{};
    for (int i = 0; i < 21; ++i) a.in[i] = (const float*)d_in[i];
    a.out = (float*)d_out; a.ws = (unsigned char*)d_ws;
    void* kargs[] = {&a};
    hipError_t e = hipLaunchCooperativeKernel((const void*)hymba_fwd, dim3(grid), dim3(NWAVES * 64), kargs, LDS_BYTES, stream);
    if (e != hipSuccess) fprintf(stderr, "kernel_launch: cooperative launch failed: %s (grid %d)\n", hipGetErrorString(e), grid);
}
```

```cpp
#include <hip/hip_runtime.h>
#include <hip/hip_cooperative_groups.h>
#include <cstdio>
#include <cstdint>
namespace cg = cooperative_groups;
namespace pg8 {
#define PG8_LAS __attribute__((address_space(3)))
typedef unsigned short bf16_t;
typedef short bf16x8 __attribute__((ext_vector_type(8)));
typedef float f32x4 __attribute__((ext_vector_type(4)));
typedef unsigned u32x4 __attribute__((ext_vector_type(4)));
constexpr int BM = 256, BK = 64, HALF = 128, HTB = HALF * BK * 2  , STAGE_BYTES = 8 * HTB, NXCD = 8, WGM = 8;

__host__ __device__ __forceinline__ int lds_byte(int r, int c) { const int st = (r >> 4) * 2 + (c >> 5), rr = r & 15, cc = c & 31, ob = rr * 64 + cc * 2; return st * 1024 + (ob ^ (((ob >> 9) & 1) << 5)); }
__host__ __device__ __forceinline__ void stage_rc(int b, int& R, int& C) { const int st = b / 1024, sb = b % 1024, swz = sb ^ (((sb >> 9) & 1) << 5); R = (st >> 1) * 16 + swz / 64; C = (st & 1) * 32 + (swz % 64) / 2; }
__host__ __device__ __forceinline__ int perm32(int rho) { const int n = rho >> 4, i = rho & 15; return 8 * (i >> 2) + 4 * n + (i & 3); }

struct Unit { int pm, pn; };
struct Gemm { const bf16_t* A; const bf16_t* Bt; int M, N, K; };

struct StaticOrder {
    int nM, nN, nwg, G, c, wgm;
    __host__ __device__ void init(int M, int N, int G_, int c_, int wgm_ = WGM) { nM = M / BM; nN = N / BM; nwg = nM * nN; G = G_; c = c_; wgm = wgm_; }
    __host__ __device__ bool next(int i, Unit& u) const {
        const long L = (long)i * G + c; if (L >= nwg) return false;
        int wgid = (int)L; { const int q = nwg / NXCD, r = nwg % NXCD, xcd = wgid % NXCD, off = wgid / NXCD; wgid = (xcd < r ? xcd * (q + 1) : r * (q + 1) + (xcd - r) * q) + off; }
        const int nig = wgm * nN, gid = wgid / nig, fm = gid * wgm, gsz = (nM - fm) < wgm ? (nM - fm) : wgm;
        u.pm = fm + ((wgid % nig) % gsz); u.pn = (wgid % nig) / gsz; return true;
    }
    __device__ __forceinline__ void a_ready(const Unit&) const {}
    __device__ __forceinline__ void done(const Unit&) const {}
};

__device__ __forceinline__ unsigned cvt_pk_bf16(float lo, float hi) { unsigned r; asm volatile("v_cvt_pk_bf16_f32 %0, %1, %2" : "=v"(r) : "v"(lo), "v"(hi)); return r; }
typedef float f32x2 __attribute__((ext_vector_type(2)));
template <class Epi, class Sched, bool ALIGN_EPI = false, bool SP2 = false>
__device__ __forceinline__ void gemm_phase(PG8_LAS unsigned char* lds, const Gemm g, const Sched& S, const Epi& E) {
    int tid_ = threadIdx.x; asm volatile("" : "+v"(tid_));
    const int tid = tid_, wid = __builtin_amdgcn_readfirstlane(tid >> 6), lane = tid & 63, wr = wid >> 2, wc = wid & 3, fr = lane & 15, fq = lane >> 4;
    const int K = g.K, nt = K / BK;
    unsigned voffA[2], voffB[2];
#pragma unroll
    for (int i = 0; i < 2; ++i) { int R, C; stage_rc(tid * 16 + i * 8192, R, C); const int Rb = Epi::PERM ? ((R & ~31) + perm32(R & 31)) : R;
        const int Ra = Epi::PERMA ? ((R & ~63) + 4 * (R & 15) + ((R >> 4) & 3)) : R;
        voffA[i] = (unsigned)(Ra * K + C) * 2u; voffB[i] = (unsigned)(Rb * K + C) * 2u; }
    const size_t kstep = (size_t)(BK * 2);
    const size_t hstep = (size_t)HALF * K * 2;
    const size_t tstep = 2 * hstep;
    const unsigned ldsw = (unsigned)wid * 1024u;
    const int aoff = lds_byte(wr * 64 + fr, fq * 8), boff = lds_byte(wc * 32 + fr, fq * 8);
#define PG8_SA(b, h) (((b) * 2 + (h)) * HTB)
#define PG8_SB(b, h) ((4 + (b) * 2 + (h)) * HTB)
#define PG8_STAGE(bufoff, gbase, voff) do { _Pragma("unroll") for (int _i = 0; _i < 2; ++_i) \
        __builtin_amdgcn_global_load_lds((const unsigned*)((const char*)(gbase) + (voff)[_i]), (PG8_LAS unsigned*)(lds + (bufoff) + ldsw + _i * 8192), 16, 0, 0); } while (0)
#define PG8_LDA(dst, b, h) do { _Pragma("unroll") for (int m = 0; m < 4; ++m) _Pragma("unroll") for (int k = 0; k < 2; ++k) dst[m][k] = *(const PG8_LAS bf16x8*)(lds + PG8_SA(b, h) + aoff + m * 2048 + k * 1024); } while (0)
#define PG8_LDB(dst, b, h) do { _Pragma("unroll") for (int n = 0; n < 2; ++n) _Pragma("unroll") for (int k = 0; k < 2; ++k) dst[n][k] = *(const PG8_LAS bf16x8*)(lds + PG8_SB(b, h) + boff + n * 2048 + k * 1024); } while (0)
#define PG8_MMA(ai, bj, At, Bt) do { __builtin_amdgcn_s_setprio(1); _Pragma("unroll") for (int m = 0; m < 4; ++m) _Pragma("unroll") for (int n = 0; n < 2; ++n) _Pragma("unroll") for (int k = 0; k < 2; ++k) \
        acc[ai][bj][m][n] = __builtin_amdgcn_mfma_f32_16x16x32_bf16(Bt[n][k], At[m][k], acc[ai][bj][m][n], 0, 0, 0); __builtin_amdgcn_s_setprio(0); } while (0)
#define PG8_WAIT_V(n) asm volatile("s_waitcnt vmcnt(" #n ")" ::: "memory")
#define PG8_WAIT_L(n) asm volatile("s_waitcnt lgkmcnt(" #n ")" ::: "memory")
#define PG8_BAR __builtin_amdgcn_s_barrier()
#define PG8_SCHED __builtin_amdgcn_sched_barrier(0)
    Unit cur, nxt; int ui = 0;
    if (!S.next(0, cur)) return;
    f32x4 acc[2][2][4][2];
#pragma unroll
    for (int a = 0; a < 2; ++a)
#pragma unroll
        for (int b = 0; b < 2; ++b)
#pragma unroll
            for (int m = 0; m < 4; ++m)
#pragma unroll
                for (int n = 0; n < 2; ++n) acc[a][b][m][n] = (f32x4){0.f, 0.f, 0.f, 0.f};
    bf16x8 At[4][2], B0[2][2], B1[2][2];
    const char* cA = (const char*)g.A + (size_t)cur.pm * tstep; const char* cB = (const char*)g.Bt + (size_t)cur.pn * tstep;
    S.a_ready(cur);
    if constexpr (SP2) {
        PG8_STAGE(PG8_SB(0, 0), cB, voffB); PG8_STAGE(PG8_SB(0, 1), cB + hstep, voffB); PG8_STAGE(PG8_SA(0, 0), cA, voffA); PG8_STAGE(PG8_SA(0, 1), cA + hstep, voffA);
        if (wr == 1) PG8_BAR;
        PG8_WAIT_V(2); PG8_BAR;
        PG8_STAGE(PG8_SB(1, 0), cB + kstep, voffB); PG8_STAGE(PG8_SA(1, 0), cA + kstep, voffA); PG8_STAGE(PG8_SB(1, 1), cB + hstep + kstep, voffB);
        PG8_WAIT_V(6); PG8_BAR;
    } else {
        PG8_STAGE(PG8_SB(0, 0), cB, voffB); PG8_STAGE(PG8_SA(0, 0), cA, voffA); PG8_STAGE(PG8_SB(0, 1), cB + hstep, voffB); PG8_STAGE(PG8_SA(0, 1), cA + hstep, voffA);
        if (wr == 1) PG8_BAR;
        PG8_WAIT_V(4); PG8_BAR;
        PG8_STAGE(PG8_SB(1, 0), cB + kstep, voffB); PG8_STAGE(PG8_SA(1, 0), cA + kstep, voffA); PG8_STAGE(PG8_SB(1, 1), cB + hstep + kstep, voffB);
        PG8_WAIT_V(6); PG8_BAR;
    }
    for (;;) {
        const bool has_next = S.next(ui + 1, nxt);
        const char* nA = has_next ? (const char*)g.A + (size_t)nxt.pm * tstep : cA; const char* nB = has_next ? (const char*)g.Bt + (size_t)nxt.pn * tstep : cB;
        for (int t = 0; t < nt; t += 2) {
            const bool last = (t == nt - 2);
            const char* a1 = cA + (size_t)(t + 1) * kstep;
            const char* a2 = last ? nA : cA + (size_t)(t + 2) * kstep; const char* b2 = last ? nB : cB + (size_t)(t + 2) * kstep;
            const char* a3 = a2 + kstep; const char* b3 = b2 + kstep;
            if (last && has_next) S.a_ready(nxt);
            if constexpr (SP2) {
            PG8_LDB(B0, 0, 0); PG8_LDB(B1, 0, 1); PG8_SCHED; PG8_LDA(At, 0, 0); PG8_STAGE(PG8_SA(1, 1), a1 + hstep, voffA);
            PG8_WAIT_V(8); PG8_WAIT_L(0); PG8_BAR; PG8_MMA(0, 0, At, B0); PG8_MMA(0, 1, At, B1); PG8_BAR; PG8_SCHED;
            PG8_LDA(At, 0, 1); PG8_STAGE(PG8_SB(0, 0), b2, voffB); PG8_STAGE(PG8_SB(0, 1), b2 + hstep, voffB); PG8_STAGE(PG8_SA(0, 0), a2, voffA);
            PG8_WAIT_V(8); PG8_WAIT_L(0); PG8_BAR; PG8_MMA(1, 0, At, B0); PG8_MMA(1, 1, At, B1); PG8_BAR; PG8_SCHED;
            PG8_LDB(B0, 1, 0); PG8_LDB(B1, 1, 1); PG8_SCHED; PG8_LDA(At, 1, 0); PG8_STAGE(PG8_SA(0, 1), a2 + hstep, voffA);
            PG8_WAIT_V(8); PG8_WAIT_L(0); PG8_BAR; PG8_MMA(0, 0, At, B0); PG8_MMA(0, 1, At, B1); PG8_BAR; PG8_SCHED;
            PG8_LDA(At, 1, 1); PG8_STAGE(PG8_SB(1, 0), b3, voffB); PG8_STAGE(PG8_SB(1, 1), b3 + hstep, voffB); PG8_STAGE(PG8_SA(1, 0), a3, voffA);
            PG8_WAIT_V(8); PG8_WAIT_L(0); PG8_BAR; PG8_MMA(1, 0, At, B0); PG8_MMA(1, 1, At, B1); PG8_BAR; PG8_SCHED;
            } else {
            PG8_LDB(B0, 0, 0); PG8_SCHED; PG8_LDA(At, 0, 0); PG8_STAGE(PG8_SA(1, 1), a1 + hstep, voffA);
            PG8_WAIT_L(8); PG8_BAR; PG8_WAIT_L(0); PG8_MMA(0, 0, At, B0); PG8_BAR; PG8_SCHED;
            PG8_LDB(B1, 0, 1); PG8_STAGE(PG8_SB(0, 0), b2, voffB);
            PG8_BAR; PG8_WAIT_L(0); PG8_MMA(0, 1, At, B1); PG8_BAR;
            PG8_LDA(At, 0, 1); PG8_STAGE(PG8_SA(0, 0), a2, voffA);
            PG8_BAR; PG8_WAIT_L(0); PG8_MMA(1, 0, At, B0); PG8_BAR; PG8_SCHED;
            PG8_STAGE(PG8_SB(0, 1), b2 + hstep, voffB);
            PG8_WAIT_V(6); PG8_BAR; PG8_MMA(1, 1, At, B1); PG8_BAR;
            PG8_LDB(B0, 1, 0); PG8_SCHED; PG8_LDA(At, 1, 0); PG8_STAGE(PG8_SA(0, 1), a2 + hstep, voffA);
            PG8_WAIT_L(8); PG8_BAR; PG8_WAIT_L(0); PG8_MMA(0, 0, At, B0); PG8_BAR; PG8_SCHED;
            PG8_LDB(B1, 1, 1); PG8_STAGE(PG8_SB(1, 0), b3, voffB);
            PG8_BAR; PG8_WAIT_L(0); PG8_MMA(0, 1, At, B1); PG8_BAR;
            PG8_LDA(At, 1, 1); PG8_STAGE(PG8_SA(1, 0), a3, voffA);
            PG8_BAR; PG8_WAIT_L(0); PG8_MMA(1, 0, At, B0); PG8_BAR; PG8_SCHED;
            PG8_STAGE(PG8_SB(1, 1), b3 + hstep, voffB);
            PG8_WAIT_V(6); PG8_BAR; PG8_MMA(1, 1, At, B1); PG8_BAR;
            }
        }
        if constexpr (ALIGN_EPI) { if (wr == 0) PG8_BAR; }
        if constexpr (!Epi::AFTER_DRAIN) { E(acc, cur, wr, wc, fr, fq); S.done(cur); }
        if (!has_next) break;
#pragma unroll
        for (int a = 0; a < 2; ++a)
#pragma unroll
            for (int b = 0; b < 2; ++b)
#pragma unroll
                for (int m = 0; m < 4; ++m)
#pragma unroll
                    for (int n = 0; n < 2; ++n) acc[a][b][m][n] = (f32x4){0.f, 0.f, 0.f, 0.f};
        cur = nxt; cA = nA; cB = nB; ++ui;
        if constexpr (ALIGN_EPI) { if (wr == 1) PG8_BAR; }
    }
    PG8_WAIT_V(0);
    if constexpr (!ALIGN_EPI) { if (wr == 0) PG8_BAR; }
    PG8_BAR;
    if constexpr (Epi::AFTER_DRAIN) { E.fused(acc, cur, wr, wc, fr, fq, lds, wid, lane); S.done(cur); }
#undef PG8_SA
#undef PG8_SB
#undef PG8_STAGE
#undef PG8_LDA
#undef PG8_LDB
#undef PG8_MMA
#undef PG8_WAIT_V
#undef PG8_WAIT_L
#undef PG8_BAR
#undef PG8_SCHED
}
}

namespace pg8 {
typedef unsigned u32x2 __attribute__((ext_vector_type(2)));
constexpr float LOG2E = 1.4426950408889634f;
typedef float f32x2 __attribute__((ext_vector_type(2)));
__device__ __forceinline__ f32x2 gelu2(f32x2 x) {
    const f32x2 t = x * x;
    const f32x2 p = t * (-0.102943239f) + (-2.302208198f);
    const f32x2 a = x * p;
    f32x2 e; e.x = __builtin_amdgcn_exp2f(a.x); e.y = __builtin_amdgcn_exp2f(a.y);
    const f32x2 d = e + 1.0f;
    f32x2 r; r.x = __builtin_amdgcn_rcpf(d.x); r.y = __builtin_amdgcn_rcpf(d.y);
    return x * r;
}
__device__ __forceinline__ float gelu_tanh(float x) { const f32x2 r = gelu2((f32x2){x, x}); return r.x; }
__device__ __forceinline__ f32x4 gelu4(f32x4 v) { const f32x2 a = gelu2((f32x2){v[0], v[1]}), b = gelu2((f32x2){v[2], v[3]}); return (f32x4){a.x, a.y, b.x, b.y}; }
__device__ __forceinline__ float sigmoidf_(float x) { return __builtin_amdgcn_rcpf(1.0f + __builtin_amdgcn_exp2f(-LOG2E * x)); }
__device__ __forceinline__ u32x4 pack8(f32x4 v0, f32x4 v1) { u32x4 w; w.x = cvt_pk_bf16(v0[0], v0[1]); w.y = cvt_pk_bf16(v0[2], v0[3]); w.z = cvt_pk_bf16(v1[0], v1[1]); w.w = cvt_pk_bf16(v1[2], v1[3]); return w; }
__device__ __forceinline__ float dot4(f32x4 a) { return (a[0] * a[0] + a[1] * a[1]) + (a[2] * a[2] + a[3] * a[3]); }
__device__ __forceinline__ float rs_of(const float* ssq, int row) {
    return __builtin_amdgcn_rsqf(ssq[row] * (1.0f / 1024.0f) + 1e-6f);
}

struct EpiIn {
    static constexpr bool PERM = true, AFTER_DRAIN = false, PERMA = false;
    bf16_t* Z; const float* rstd;
    __device__ __forceinline__ void operator()(const f32x4 (&acc)[2][2][4][2], const Unit& u, int wr, int wc, int fr, int fq) const {
        const int row0 = u.pm * BM + wr * 64 + fr, col0 = u.pn * BM + wc * 32 + 8 * fq; const bool gel = u.pn >= 3;
        float rsv[2][4];
#pragma unroll
        for (int ai = 0; ai < 2; ++ai)
#pragma unroll
            for (int m = 0; m < 4; ++m) rsv[ai][m] = rstd[row0 + ai * HALF + m * 16];
#pragma unroll
        for (int ai = 0; ai < 2; ++ai)
#pragma unroll
            for (int m = 0; m < 4; ++m) { const int row = row0 + ai * HALF + m * 16; const float rs = rsv[ai][m]; bf16_t* rowp = Z + (size_t)row * 1792 + col0;
#pragma unroll
                for (int bj = 0; bj < 2; ++bj) { f32x4 v0 = acc[ai][bj][m][0] * rs, v1 = acc[ai][bj][m][1] * rs;
                    if (gel) { v0 = gelu4(v0); v1 = gelu4(v1); }
                    *(u32x4*)(rowp + bj * HALF) = pack8(v0, v1); } }
    }
};
struct EpiPlain {
    static constexpr bool PERM = true, AFTER_DRAIN = false, PERMA = false;
    bf16_t* O; int ldc;
    __device__ __forceinline__ void operator()(const f32x4 (&acc)[2][2][4][2], const Unit& u, int wr, int wc, int fr, int fq) const {
        const int row0 = u.pm * BM + wr * 64 + fr, col0 = u.pn * BM + wc * 32 + 8 * fq;
#pragma unroll
        for (int ai = 0; ai < 2; ++ai)
#pragma unroll
            for (int m = 0; m < 4; ++m) { bf16_t* rowp = O + (size_t)(row0 + ai * HALF + m * 16) * ldc + col0;
#pragma unroll
                for (int bj = 0; bj < 2; ++bj) *(u32x4*)(rowp + bj * HALF) = pack8(acc[ai][bj][m][0], acc[ai][bj][m][1]); }
    }
};
__device__ __forceinline__ void unpack8(u32x4 pw, f32x4& p0, f32x4& p1) {
    p0 = (f32x4){__uint_as_float(pw.x << 16), __uint_as_float(pw.x & 0xffff0000u), __uint_as_float(pw.y << 16), __uint_as_float(pw.y & 0xffff0000u)};
    p1 = (f32x4){__uint_as_float(pw.z << 16), __uint_as_float(pw.z & 0xffff0000u), __uint_as_float(pw.w << 16), __uint_as_float(pw.w & 0xffff0000u)};
}
template <bool BF, bool RS> struct EpiRes {
    static constexpr bool PERM = true, AFTER_DRAIN = false, PERMA = false;
    const void* base; bf16_t* outb; float* ssq; const float* rowscale;
    __device__ __forceinline__ void operator()(const f32x4 (&acc)[2][2][4][2], const Unit& u, int wr, int wc, int fr, int fq) const {
        const int row0 = u.pm * BM + wr * 64 + fr, col0 = u.pn * BM + wc * 32 + 8 * fq;
        f32x4 pf[4][2][2]; u32x4 pb[4][2];
#define ER_LOAD(ai_, m_) do { _Pragma("unroll") for (int bj = 0; bj < 2; ++bj) { const size_t off = (size_t)(row0 + (ai_) * HALF + (m_) * 16) * 1024 + col0 + bj * HALF; \
            if (BF) pb[m_][bj] = *(const u32x4*)((const bf16_t*)base + off); else { pf[m_][bj][0] = *(const f32x4*)((const float*)base + off); pf[m_][bj][1] = *(const f32x4*)((const float*)base + off + 4); } } } while (0)
        float rsc[2][4];
#pragma unroll
        for (int ai = 0; ai < 2; ++ai)
#pragma unroll
            for (int m = 0; m < 4; ++m) rsc[ai][m] = RS ? rowscale[row0 + ai * HALF + m * 16] : 1.0f;
#pragma unroll
        for (int m = 0; m < 4; ++m) ER_LOAD(0, m);
#pragma unroll
        for (int ai = 0; ai < 2; ++ai)
#pragma unroll
            for (int m = 0; m < 4; ++m) { const int row = row0 + ai * HALF + m * 16; float q = 0.f;
#pragma unroll
                for (int bj = 0; bj < 2; ++bj) { const size_t off = (size_t)row * 1024 + col0 + bj * HALF;
                    f32x4 b0, b1;
                    if (BF) unpack8(pb[m][bj], b0, b1); else { b0 = pf[m][bj][0]; b1 = pf[m][bj][1]; }
                    const f32x4 h0 = RS ? b0 + acc[ai][bj][m][0] * rsc[ai][m] : b0 + acc[ai][bj][m][0], h1 = RS ? b1 + acc[ai][bj][m][1] * rsc[ai][m] : b1 + acc[ai][bj][m][1];
                    *(u32x4*)(outb + off) = pack8(h0, h1);
                    q += dot4(h0) + dot4(h1); }
                if (ai == 0) ER_LOAD(1, m);
                q += __shfl_xor(q, 16); q += __shfl_xor(q, 32);
                if (fq == 0) (void)__hip_atomic_fetch_add(ssq + row, q, __ATOMIC_RELAXED, __HIP_MEMORY_SCOPE_AGENT); }
#undef ER_LOAD
    }
};
struct EpiPle {
    static constexpr bool PERM = true, AFTER_DRAIN = false, PERMA = false;
    const bf16_t* h2; const bf16_t* pp; float* out; const float* ssq_in; float* ssq_out; unsigned* cnt; const float* gfin;
    __device__ __forceinline__ void operator()(f32x4 (&acc)[2][2][4][2], const Unit& u, int wr, int wc, int fr, int fq) const {
        const int row0 = u.pm * BM + wr * 64 + fr, col0 = u.pn * BM + wc * 32 + 8 * fq;
        float rsv[2][4];
#pragma unroll
        for (int ai = 0; ai < 2; ++ai)
#pragma unroll
            for (int m = 0; m < 4; ++m) rsv[ai][m] = ssq_in[row0 + ai * HALF + m * 16];
        u32x4 ph[4][2], pq[4][2];
#define EP_LOAD(ai_, m_) do { _Pragma("unroll") for (int bj = 0; bj < 2; ++bj) { const size_t off = (size_t)(row0 + (ai_) * HALF + (m_) * 16) * 1024 + col0 + bj * HALF; \
            ph[m_][bj] = *(const u32x4*)(h2 + off); pq[m_][bj] = *(const u32x4*)(pp + off); } } while (0)
#pragma unroll
        for (int m = 0; m < 4; ++m) EP_LOAD(0, m);
#pragma unroll
        for (int ai = 0; ai < 2; ++ai)
#pragma unroll
            for (int m = 0; m < 4; ++m) { const int row = row0 + ai * HALF + m * 16; const float rs = __builtin_amdgcn_rsqf(rsv[ai][m] * (1.0f / 1024.0f) + 1e-6f); float q = 0.f;
#pragma unroll
                for (int bj = 0; bj < 2; ++bj) {
                    f32x4 b0, b1, p0, p1; unpack8(ph[m][bj], b0, b1); unpack8(pq[m][bj], p0, p1);
                    const f32x4 a0 = acc[ai][bj][m][0] * rs, a1 = acc[ai][bj][m][1] * rs;
                    f32x4 h0, h1;
#pragma unroll
                    for (int j = 0; j < 4; ++j) { h0[j] = b0[j] + p0[j] * sigmoidf_(a0[j]); h1[j] = b1[j] + p1[j] * sigmoidf_(a1[j]); }
                    acc[ai][bj][m][0] = h0; acc[ai][bj][m][1] = h1;
                    q += dot4(h0) + dot4(h1); }
                if (ai == 0) EP_LOAD(1, m);
                q += __shfl_xor(q, 16); q += __shfl_xor(q, 32);
                if (fq == 0) (void)__hip_atomic_fetch_add(ssq_out + row, q, __ATOMIC_RELAXED, __HIP_MEMORY_SCOPE_AGENT); }
#undef EP_LOAD
        asm volatile("s_waitcnt vmcnt(0)" ::: "memory");
        unsigned* pc = cnt + 64 * u.pm;
        if (fq == 0 && fr == 0) (void)__hip_atomic_fetch_add(pc, 1u, __ATOMIC_RELAXED, __HIP_MEMORY_SCOPE_AGENT);
        f32x4 gf[2][2];
#pragma unroll
        for (int bj = 0; bj < 2; ++bj) { gf[bj][0] = *(const f32x4*)(gfin + col0 + bj * HALF); gf[bj][1] = *(const f32x4*)(gfin + col0 + bj * HALF + 4); }
        { unsigned sp = 0u;
          while ((unsigned)__builtin_amdgcn_readfirstlane(__hip_atomic_load(pc, __ATOMIC_RELAXED, __HIP_MEMORY_SCOPE_AGENT)) < 32u) { __builtin_amdgcn_s_sleep(2); if (++sp > (1u << 16)) break; } }
        asm volatile("" ::: "memory");
        float fin[2][4];
#pragma unroll
        for (int ai = 0; ai < 2; ++ai)
#pragma unroll
            for (int m = 0; m < 4; ++m) fin[ai][m] = __hip_atomic_load(ssq_out + row0 + ai * HALF + m * 16, __ATOMIC_RELAXED, __HIP_MEMORY_SCOPE_AGENT);
#pragma unroll
        for (int ai = 0; ai < 2; ++ai)
#pragma unroll
            for (int m = 0; m < 4; ++m) { const int row = row0 + ai * HALF + m * 16;
                const float rs = __builtin_amdgcn_rsqf(fin[ai][m] * (1.0f / 1024.0f) + 1e-6f);
#pragma unroll
                for (int bj = 0; bj < 2; ++bj) { float* o = out + (size_t)row * 1024 + col0 + bj * HALF;
                    *(f32x4*)o = acc[ai][bj][m][0] * rs * gf[bj][0]; *(f32x4*)(o + 4) = acc[ai][bj][m][1] * rs * gf[bj][1]; } }
    }
};
struct EpiGlu {
    static constexpr bool PERM = true, AFTER_DRAIN = false, PERMA = true;
    bf16_t* act; const float* ssq_in; const float* conv_w; const float* conv_b; float* side;
    __device__ __forceinline__ void operator()(const f32x4 (&acc)[2][2][4][2], const Unit& u, int wr, int wc, int fr, int fq) const {
        const int ch0 = u.pn * 128 + wc * 32 + 8 * fq;
        f32x4 rq[2];
#pragma unroll
        for (int ai = 0; ai < 2; ++ai) rq[ai] = *(const f32x4*)(ssq_in + u.pm * BM + ai * HALF + wr * 64 + 4 * fr);
        f32x4 w0[2], w1[2], w2[2], cb[2];
#pragma unroll
        for (int n = 0; n < 2; ++n) { w0[n] = *(const f32x4*)(conv_w + ch0 + 4 * n); w1[n] = *(const f32x4*)(conv_w + 2816 + ch0 + 4 * n); w2[n] = *(const f32x4*)(conv_w + 5632 + ch0 + 4 * n); cb[n] = *(const f32x4*)(conv_b + ch0 + 4 * n); }
#pragma unroll
        for (int ai = 0; ai < 2; ++ai) {
            const int rowg = u.pm * BM + ai * HALF + wr * 64;
            const int grp = rowg >> 6;
            float rs[4];
#pragma unroll
            for (int m = 0; m < 4; ++m) rs[m] = __builtin_amdgcn_rsqf(rq[ai][m] * (1.0f / 1024.0f) + 1e-6f);
            u32x2 pk[4][2];
#pragma unroll
            for (int n = 0; n < 2; ++n) {
                f32x4 g[4], up0, dn3;
#pragma unroll
                for (int m = 0; m < 4; ++m) g[m] = acc[ai][0][m][n] * rs[m];
#pragma unroll
                for (int j = 0; j < 4; ++j) { up0[j] = __int_as_float(__builtin_amdgcn_update_dpp(0, __float_as_int(g[3][j]), 0x111, 0xf, 0xf, true));
                                              dn3[j] = __int_as_float(__builtin_amdgcn_update_dpp(0, __float_as_int(g[0][j]), 0x101, 0xf, 0xf, true)); }
#pragma unroll
                for (int m = 0; m < 4; ++m) {
                    const f32x4 up = m > 0 ? g[m > 0 ? m - 1 : 0] : up0, dn = m < 3 ? g[m < 3 ? m + 1 : 3] : dn3;
                    const f32x4 s = w1[n] * g[m] + w0[n] * up + w2[n] * dn + cb[n];
                    const f32x4 val = acc[ai][1][m][n] * rs[m];
                    const f32x4 a = gelu4(s) * val;
                    pk[m][n].x = cvt_pk_bf16(a[0], a[1]); pk[m][n].y = cvt_pk_bf16(a[2], a[3]);
                    if (m == 0) { if (fr == 0) { float* sp = side + (size_t)((grp * 2 + 0) * 3) * 2816 + ch0 + 4 * n; *(f32x4*)sp = s; *(f32x4*)(sp + 2816) = val; *(f32x4*)(sp + 5632) = g[m]; } }
                    if (m == 3) { if (fr == 15) { float* sp = side + (size_t)((grp * 2 + 1) * 3) * 2816 + ch0 + 4 * n; *(f32x4*)sp = s; *(f32x4*)(sp + 2816) = val; *(f32x4*)(sp + 5632) = g[m]; } }
                }
            }
#pragma unroll
            for (int m = 0; m < 4; ++m) { u32x4 w; w.x = pk[m][0].x; w.y = pk[m][0].y; w.z = pk[m][1].x; w.w = pk[m][1].y;
                *(u32x4*)(act + (size_t)(rowg + 4 * fr + m) * 2816 + ch0) = w; }
        }
    }
};
}

namespace pg8 {
struct BalancedOrder {
    StaticOrder so; int c;
    __host__ __device__ void init(int M, int N, int G_, int c_) { so.init(M, N, 1, 0); c = c_; }
    __host__ __device__ bool next(int i, Unit& u) const {
        int L;
        if (c < 128) { if (i >= 1) return false; L = c; } else { if (i >= 3) return false; L = 128 + (c - 128) * 3 + i; }
        return so.next(L, u);
    }
    __device__ __forceinline__ void a_ready(const Unit&) const {}
    __device__ __forceinline__ void done(const Unit&) const {}
};
}

#define LAS __attribute__((address_space(3)))
typedef unsigned short bf16;
typedef unsigned v4u __attribute__((ext_vector_type(4)));
typedef unsigned v2u __attribute__((ext_vector_type(2)));
typedef float f32x4 __attribute__((ext_vector_type(4)));
typedef short bf16x8 __attribute__((ext_vector_type(8)));
typedef short s16x4 __attribute__((ext_vector_type(4)));
#define LDS_WAIT() asm volatile("s_waitcnt lgkmcnt(0)" ::: "memory")
#define GAS __attribute__((address_space(1)))

constexpr int NWAVES = 8;
constexpr int SEQ = 2048, D = 1024, M = 16 * SEQ, INW = 1792, DFF = 2816, PLE = 256;
constexpr size_t MiB = 1u << 20;
constexpr size_t WS_WIN = 0, WS_WOUT = 4 * MiB, WS_WUP = 6 * MiB, WS_WDOWN = 17 * MiB, WS_WGATE = 23 * MiB, WS_WPROJ = 25 * MiB;
constexpr size_t WS_RSTD1 = 26 * MiB; constexpr size_t WS_SGUW = 27 * MiB;
constexpr size_t WS_PP = 40 * MiB;
constexpr size_t WS_XB = 104 * MiB;
constexpr size_t WS_MERGED = 296 * MiB;
constexpr size_t WS_SIDE = 104 * MiB;
constexpr size_t WS_H2B = 104 * MiB;
constexpr size_t WS_PB = 168 * MiB;
constexpr size_t WS_Z = 184 * MiB;
constexpr size_t WS_H1B = 184 * MiB;
constexpr size_t WS_H3B = 232 * MiB + 16 * MiB;
constexpr size_t WS_ACT = 296 * MiB;
constexpr size_t WS_END = 472 * MiB;
constexpr size_t WS_CTL = 33 * MiB;
constexpr size_t WS_CNT = WS_CTL + 16384;
constexpr size_t WS_SSQ1 = WS_CTL + 65536, WS_SSQ2 = WS_SSQ1 + 131072, WS_SSQ3 = WS_SSQ2 + 131072; constexpr size_t CTL_BYTES = 65536 + 3 * 131072;
constexpr int MISC_OFF = 147456 - 256;
constexpr int LDS_BYTES = 147456;

__device__ __forceinline__ unsigned f2bf(float f) { unsigned u = __builtin_bit_cast(unsigned, f); return (u + 0x7fffu + ((u >> 16) & 1u)) >> 16; }
__device__ __forceinline__ unsigned pk2(float lo, float hi) { return f2bf(lo) | (f2bf(hi) << 16); }
__device__ __forceinline__ float bf2f(unsigned short u) { return __uint_as_float((unsigned)u << 16); }
__device__ __forceinline__ float wave_sum(float v) {
#pragma unroll
    for (int o = 1; o < 64; o <<= 1) v += __shfl_xor(v, o);
    return v;
}

__device__ __forceinline__ void p0_transpose_item(const float* W, int K, int N, bf16* WT, const float* gk, bool upperm, LAS float* scr, int item, int lane) {
    const int nblk = N / 32, kb = item / nblk, nb = item % nblk, k0 = 64 * kb, n0 = 32 * nb;
    float wv[32];
#pragma unroll
    for (int i = 0; i < 32; ++i) wv[i] = W[(size_t)(k0 + 2 * i + (lane >> 5)) * N + n0 + (lane & 31)];
#pragma unroll
    for (int i = 0; i < 32; ++i) { const int kk = 2 * i + (lane >> 5); float w = wv[i]; if (gk) w *= gk[k0 + kk]; scr[kk * 33 + (lane & 31)] = w; }
    LDS_WAIT(); asm volatile("" ::: "memory");
    const int c = lane & 7;
#pragma unroll
    for (int j = 0; j < 4; ++j) { const int n = (lane >> 3) + 8 * j; const LAS float* s = scr + (8 * c) * 33 + n;
        v4u o; o.x = pk2(s[0 * 33], s[1 * 33]); o.y = pk2(s[2 * 33], s[3 * 33]); o.z = pk2(s[4 * 33], s[5 * 33]); o.w = pk2(s[6 * 33], s[7 * 33]);
        int nn = n0 + n;
        if (upperm) { const bool isv = nn >= DFF; const int ch = isv ? nn - DFF : nn; nn = (ch >> 7) * 256 + (isv ? 128 : 0) + (ch & 127); }
        *(v4u*)(WT + (size_t)nn * K + k0 + 8 * c) = o; }
    LDS_WAIT(); asm volatile("" ::: "memory");
}

#define XB_TMO      128
#define XB_XCNT(j)  (256  + 64 * (j))
#define XB_XSUB(j)  (1280 + 64 * (j))
#define XB_XGEN(j)  (2304 + 64 * (j))
#define XB_TOP      3328
#define XB_TOPGEN   3392
#define XCD_BAR_WORDS 3456
#define XB_SPIN_CAP (1u << 18)

__device__ __forceinline__ unsigned xb_ld(unsigned* p)              { return __hip_atomic_load(p, __ATOMIC_RELAXED, __HIP_MEMORY_SCOPE_AGENT); }
__device__ __forceinline__ unsigned xb_add(unsigned* p, unsigned v) { return __hip_atomic_fetch_add(p, v, __ATOMIC_RELAXED, __HIP_MEMORY_SCOPE_AGENT); }
__device__ __forceinline__ unsigned xb_xcc_id() { return (unsigned)__builtin_amdgcn_s_getreg((3 << 11) | 20) & 0xFu; }
#define XB_SPIN(cond, bar) do { unsigned _sp = 0; while (cond) { __builtin_amdgcn_s_sleep(1); \
    if ((++_sp & 255u) == 0u) { if (xb_ld(&(bar)[XB_TMO])) break; if (_sp > XB_SPIN_CAP) { atomicAdd(&(bar)[XB_TMO], 1u); break; } } } } while (0)

struct XcdBarrier {
    unsigned* bar; unsigned x;
    volatile LAS unsigned* st;
};

__device__ __forceinline__ XcdBarrier xcd_barrier_post(unsigned* bar, volatile LAS unsigned* st) {
    XcdBarrier b; b.bar = bar; b.x = xb_xcc_id(); b.st = st;
    if (threadIdx.x == 0) (void)xb_add(&bar[XB_XCNT(b.x)], 1u);
    return b;
}
__device__ __forceinline__ void xcd_barrier_complete(unsigned* bar, unsigned x, unsigned& nloc, unsigned& nx) {
    const unsigned G = gridDim.x * gridDim.y * gridDim.z;
    unsigned sum, cnt, mine, sp = 0u;
    for (;;) {
        sum = 0u; cnt = 0u; mine = 0u;
#pragma unroll
        for (unsigned j = 0; j < 16; ++j) { const unsigned c = xb_ld(&bar[XB_XCNT(j)]); sum += c; cnt += (c > 0u) ? 1u : 0u; mine = (j == x) ? c : mine; }
        if (sum == G) break;
        __builtin_amdgcn_s_sleep(1);
        if ((++sp & 255u) == 0u) { if (xb_ld(&bar[XB_TMO])) break; if (sp > XB_SPIN_CAP) { atomicAdd(&bar[XB_TMO], 1u); break; } }
    }
    nloc = mine > 0u ? mine : 1u; nx = cnt > 0u ? cnt : 1u;
}

__device__ __forceinline__ void xcd_barrier(const XcdBarrier& b) {
    asm volatile("s_waitcnt vmcnt(0)" ::: "memory");
    __syncthreads();
    if (threadIdx.x == 0) {
        unsigned* bar = b.bar;
        __builtin_amdgcn_s_waitcnt(0);
        unsigned nloc = b.st[0], nx = b.st[1];
        if (nloc == 0u) { xcd_barrier_complete(bar, b.x, nloc, nx); b.st[0] = nloc; b.st[1] = nx; }
        const unsigned old = xb_add(&bar[XB_XSUB(b.x)], 1u);
        const unsigned gen = old / nloc;
        if (old + 1u == (gen + 1u) * nloc) {
            __builtin_amdgcn_fence(__ATOMIC_RELEASE, "agent");
            asm volatile("s_waitcnt vmcnt(0)" ::: "memory");
            const unsigned og = xb_add(&bar[XB_TOP], 1u);
            const unsigned tg = og / nx;
            if (og + 1u == (tg + 1u) * nx) xb_add(&bar[XB_TOPGEN], 1u);
            else XB_SPIN(xb_ld(&bar[XB_TOPGEN]) == tg, bar);
            __builtin_amdgcn_fence(__ATOMIC_ACQUIRE, "agent");
            xb_add(&bar[XB_XGEN(b.x)], 1u);
            asm volatile("s_waitcnt vmcnt(0)" ::: "memory");
        } else {
            XB_SPIN(xb_ld(&bar[XB_XGEN(b.x)]) == gen, bar);
            __builtin_amdgcn_fence(__ATOMIC_ACQUIRE, "agent");
            asm volatile("s_waitcnt vmcnt(0)" ::: "memory");
        }
    }
    __syncthreads();
}

struct Args { const float* in[21]; float* out; unsigned char* ws; };

constexpr int KS_STRIDE = 144, VT_STRIDE = 1032, KS_OFF = 0, VT_OFF = 400 * 144;
__device__ __forceinline__ float attn_unit(LAS unsigned char* lds, const bf16* z, bf16* merged, const float* sink, int b, int qb, int tid, int wid, int lane) {
    const int i = lane & 15, g = lane >> 4;
    const size_t zrow0 = (size_t)b * SEQ;
    const int kpos0 = 128 * (qb - 1);
    const size_t qrow = zrow0 + 128 * qb + 16 * wid + i;
    float ssq = 0.f;
    const float sinkv = sink[lane & 7];
    v4u kreg[6];
#define ATT_ISSUE_K(kvh_) do { \
        _Pragma("unroll") for (int e_ = 0; e_ < 6; ++e_) { const int c = tid + 512 * e_; const int key = c >> 3, dch = c & 7; const int pos = kpos0 + key; kreg[e_] = (v4u){0u, 0u, 0u, 0u}; \
            if ((unsigned)pos < (unsigned)SEQ) kreg[e_] = *(const v4u*)(z + (zrow0 + pos) * INW + 512 + 64 * (kvh_) + 8 * dch); } } while (0)
#define ATT_ISSUE_V(kvh_) do { \
        _Pragma("unroll") for (int e_ = 0; e_ < 3; ++e_) { const int c = tid + 512 * e_; const int dch = c / 192, kp = c % 192; const int pos = kpos0 + 2 * kp; vra[e_] = (v4u){0u, 0u, 0u, 0u}; vrb[e_] = (v4u){0u, 0u, 0u, 0u}; \
            if ((unsigned)pos < (unsigned)SEQ) { const bf16* src = z + (zrow0 + pos) * INW + 640 + 64 * (kvh_) + 8 * dch; vra[e_] = *(const v4u*)src; vrb[e_] = *(const v4u*)(src + INW); } } } while (0)
#define ATT_WRITE() do { \
        _Pragma("unroll") for (int e_ = 0; e_ < 6; ++e_) { const int c = tid + 512 * e_; const int key = c >> 3, dch = c & 7; *(LAS v4u*)(lds + KS_OFF + key * KS_STRIDE + dch * 16) = kreg[e_]; } \
        _Pragma("unroll") for (int e_ = 0; e_ < 3; ++e_) { const int c = tid + 512 * e_; const int dch = c / 192, kp = c % 192; LAS unsigned char* dst = lds + VT_OFF + (8 * dch) * VT_STRIDE + kp * 4; \
            _Pragma("unroll") for (int e = 0; e < 4; ++e) { const unsigned a = vra[e_][e], bb = vrb[e_][e]; \
                *(LAS unsigned*)(dst + (2 * e) * VT_STRIDE) = (a & 0xffffu) | (bb << 16); \
                *(LAS unsigned*)(dst + (2 * e + 1) * VT_STRIDE) = (a >> 16) | (bb & 0xffff0000u); } } } while (0)
    ATT_ISSUE_K(0);
    bf16x8 qn0 = *(const bf16x8*)(z + qrow * INW + 8 * g), qn1 = *(const bf16x8*)(z + qrow * INW + 32 + 8 * g);
    for (int c = tid; c < 64 * 12; c += 512) { const int d = c / 12, k = c % 12; *(LAS unsigned*)(lds + VT_OFF + d * VT_STRIDE + 768 + k * 4) = 0u; }
#pragma unroll 1
    for (int kvh = 0; kvh < 2; ++kvh) {
        { v4u vra[3], vrb[3]; ATT_ISSUE_V(kvh);
        __syncthreads();
        ATT_WRITE(); }
        __syncthreads();
        if (kvh == 0) ATT_ISSUE_K(1);
#pragma unroll 1
        for (int hh = 0; hh < 4; ++hh) {
            const int h = kvh * 4 + hh;
            const bf16x8 qf0 = qn0, qf1 = qn1;
            { const int hn = (h + 1) & 7; qn0 = *(const bf16x8*)(z + qrow * INW + 64 * hn + 8 * g); qn1 = *(const bf16x8*)(z + qrow * INW + 64 * hn + 32 + 8 * g); }
            const float slope2 = __builtin_amdgcn_exp2f(-(float)(h + 1)) * pg8::LOG2E;
            const float sink2 = __int_as_float(__builtin_amdgcn_readlane(__float_as_int(sinkv), h)) * pg8::LOG2E;
            int iv = i - 4 * g, pv = kpos0 + 16 * wid + 4 * g; asm volatile("" : "+v"(iv), "+v"(pv));
            f32x4 s[17];
#pragma unroll
            for (int j = 0; j < 17; ++j) {
                const LAS unsigned char* kp = lds + KS_OFF + (16 * (wid + j) + i) * KS_STRIDE + g * 16;
                const bf16x8 k0 = *(const LAS bf16x8*)kp, k1 = *(const LAS bf16x8*)(kp + 64);
                f32x4 a = (f32x4){0.f, 0.f, 0.f, 0.f};
                a = __builtin_amdgcn_mfma_f32_16x16x32_bf16(k0, qf0, a, 0, 0, 0);
                a = __builtin_amdgcn_mfma_f32_16x16x32_bf16(k1, qf1, a, 0, 0, 0);
                s[j] = a;
                if ((j & 7) == 7) __builtin_amdgcn_sched_barrier(0);
            }
            __builtin_amdgcn_sched_barrier(0);
            float mraw = s[0][0];
#pragma unroll
            for (int j = 0; j < 17; ++j)
#pragma unroll
                for (int r = 0; r < 4; ++r) mraw = fmaxf(mraw, s[j][r]);
            mraw = fmaxf(mraw, __shfl_xor(mraw, 16)); mraw = fmaxf(mraw, __shfl_xor(mraw, 32));
            const float mx = fmaxf(mraw * (0.125f * pg8::LOG2E), sink2);
            const float fiv = (float)iv;
            const float baseN = -__builtin_fmaf(slope2, fiv, mx);
            const float baseP = __builtin_fmaf(slope2, fiv, -mx);
#pragma unroll
            for (int j = 0; j < 17; ++j)
#pragma unroll
                for (int r = 0; r < 4; ++r) { const float c = (float)(16 * j + r - 128); float bias;
                    if (j <= 7) bias = __builtin_fmaf(slope2, c, baseN); else if (j >= 9) bias = __builtin_fmaf(-slope2, c, baseP); else bias = -__builtin_fmaf(__builtin_fabsf(c - fiv), slope2, mx);
                    float e = __builtin_amdgcn_exp2f(__builtin_fmaf(s[j][r], 0.125f * pg8::LOG2E, bias));
                    if (j == 0 || j == 16) e = (__builtin_fabsf(c - fiv) <= 128.f) ? e : 0.f;
                    s[j][r] = e; }
            if (qb == 0 || qb == 15) {
                asm volatile("" ::: "memory");
#pragma unroll
                for (int j = 0; j < 17; ++j)
#pragma unroll
                    for (int r = 0; r < 4; ++r) { const int pos = pv + 16 * j + r; s[j][r] = ((unsigned)pos < (unsigned)SEQ) ? s[j][r] : 0.f; }
            }
            float sum = 0.f;
#pragma unroll
            for (int j = 0; j < 17; ++j) sum += (s[j][0] + s[j][1]) + (s[j][2] + s[j][3]);
            sum += __shfl_xor(sum, 16); sum += __shfl_xor(sum, 32);
            const float inv = __builtin_amdgcn_rcpf(sum + __builtin_amdgcn_exp2f(sink2 - mx));
            f32x4 o[4];
#pragma unroll
            for (int dt = 0; dt < 4; ++dt) o[dt] = (f32x4){0.f, 0.f, 0.f, 0.f};
#pragma unroll
            for (int sl = 0; sl < 9; ++sl) {
                v4u pw; pw.x = pg8::cvt_pk_bf16(s[2 * sl][0], s[2 * sl][1]); pw.y = pg8::cvt_pk_bf16(s[2 * sl][2], s[2 * sl][3]);
                if (sl < 8) { pw.z = pg8::cvt_pk_bf16(s[(2 * sl + 1) & 15][0], s[(2 * sl + 1) & 15][1]); pw.w = pg8::cvt_pk_bf16(s[(2 * sl + 1) & 15][2], s[(2 * sl + 1) & 15][3]); }
                else { pw.z = 0u; pw.w = 0u; }
                const bf16x8 pf = __builtin_bit_cast(bf16x8, pw);
#pragma unroll
                for (int dt = 0; dt < 4; ++dt) {
                    const LAS unsigned char* vp = lds + VT_OFF + (16 * dt + i) * VT_STRIDE + (16 * (wid + 2 * sl) + 4 * g) * 2;
                    const v2u lo = *(const LAS v2u*)vp, hi = *(const LAS v2u*)(vp + 32);
                    const v4u vw = (v4u){lo.x, lo.y, hi.x, hi.y};
                    o[dt] = __builtin_amdgcn_mfma_f32_16x16x32_bf16(__builtin_bit_cast(bf16x8, vw), pf, o[dt], 0, 0, 0);
                }
                if (sl & 1) __builtin_amdgcn_sched_barrier(0);
            }
            __builtin_amdgcn_sched_barrier(0);
#pragma unroll
            for (int dt = 0; dt < 4; ++dt) { o[dt] = o[dt] * inv; ssq += pg8::dot4(o[dt]);
                v2u w; w.x = pg8::cvt_pk_bf16(o[dt][0], o[dt][1]); w.y = pg8::cvt_pk_bf16(o[dt][2], o[dt][3]);
                *(v2u*)(merged + qrow * 1024 + 64 * h + 16 * dt + 4 * g) = w; }
        }
    }
#undef ATT_ISSUE_K
#undef ATT_ISSUE_V
#undef ATT_WRITE
    ssq += __shfl_xor(ssq, 16); ssq += __shfl_xor(ssq, 32);
    return ssq;
}

constexpr int VV_STRIDE = 272;
__device__ __forceinline__ void sgu_unit(LAS unsigned char* lds, const bf16* z, bf16* merged, const float* ln_g, const float* ln_b, const bf16* sw, const float* sb, float ssq_a, float* rsa, int b, int ck, int tid, int wid, int lane) {
    const int i = lane & 15, g = lane >> 4;
    const size_t R0 = (size_t)b * SEQ + 128 * ck;
    const size_t orow = R0 + 16 * wid + i;
    bf16x8 wfA[4][4];
#define SGU_WLOAD4(dst, h0_) do { _Pragma("unroll") for (int hh_ = 0; hh_ < 4; ++hh_) { const bf16* wrow_ = sw + ((size_t)((h0_) + hh_) * 128 + 16 * wid + i) * 128 + 8 * g; \
        _Pragma("unroll") for (int ks = 0; ks < 4; ++ks) dst[hh_][ks] = *(const bf16x8*)(wrow_ + 32 * ks); } } while (0)
#define SGU_WLOAD1(dst, h_) do { const bf16* wrow_ = sw + ((size_t)(h_) * 128 + 16 * wid + i) * 128 + 8 * g; \
        _Pragma("unroll") for (int ks = 0; ks < 4; ++ks) dst[ks] = *(const bf16x8*)(wrow_ + 32 * ks); } while (0)
    SGU_WLOAD1(wfA[0], 0); SGU_WLOAD1(wfA[1], 1);
    v2u uw[8][4]; float biasv[8];
#pragma unroll
    for (int h = 0; h < 8; ++h) biasv[h] = sb[h * 128 + 16 * wid + i];
#pragma unroll
    for (int h = 0; h < 4; ++h)
#pragma unroll
        for (int ct = 0; ct < 4; ++ct) uw[h][ct] = *(const v2u*)(z + orow * INW + 768 + 64 * h + 16 * ct + 4 * g);
    __syncthreads();
    {
        float lg[8], lb[8];
#pragma unroll
        for (int e = 0; e < 8; ++e) { lg[e] = ln_g[lane + 64 * e]; lb[e] = ln_b[lane + 64 * e]; }
        unsigned short xr[4][8];
        const bf16* rbase = z + (R0 + 16 * wid) * INW + 1280 + lane;
#pragma unroll
        for (int rr = 0; rr < 4; ++rr)
#pragma unroll
            for (int e = 0; e < 8; ++e) xr[rr][e] = rbase[(size_t)rr * INW + 64 * e];
#pragma unroll 1
        for (int it = 0; it < 4; ++it) { const int s = 16 * wid + 4 * it;
            float x[4][8], sm[4], sq[4];
#pragma unroll
            for (int rr = 0; rr < 4; ++rr)
#pragma unroll
                for (int e = 0; e < 8; ++e) x[rr][e] = bf2f(xr[rr][e]);
            { const int itn = (it + 1) & 3;
#pragma unroll
              for (int rr = 0; rr < 4; ++rr)
#pragma unroll
                for (int e = 0; e < 8; ++e) xr[rr][e] = rbase[(size_t)(4 * itn + rr) * INW + 64 * e]; }
#pragma unroll
            for (int rr = 0; rr < 4; ++rr) { sm[rr] = 0.f; sq[rr] = 0.f;
#pragma unroll
                for (int e = 0; e < 8; ++e) { sm[rr] += x[rr][e]; sq[rr] += x[rr][e] * x[rr][e]; } }
#pragma unroll
            for (int o = 1; o < 64; o <<= 1)
#pragma unroll
                for (int rr = 0; rr < 4; ++rr) { sm[rr] += __shfl_xor(sm[rr], o); sq[rr] += __shfl_xor(sq[rr], o); }
            float mean[4], rsd[4];
#pragma unroll
            for (int rr = 0; rr < 4; ++rr) { mean[rr] = sm[rr] * (1.0f / 512.0f); const float var = fmaxf(sq[rr] * (1.0f / 512.0f) - mean[rr] * mean[rr], 0.f); rsd[rr] = __builtin_amdgcn_rsqf(var + 1e-5f); }
#pragma unroll
            for (int e = 0; e < 8; ++e) {
                const float y0 = (x[0][e] - mean[0]) * rsd[0] * lg[e] + lb[e], y1 = (x[1][e] - mean[1]) * rsd[1] * lg[e] + lb[e];
                const float y2 = (x[2][e] - mean[2]) * rsd[2] * lg[e] + lb[e], y3 = (x[3][e] - mean[3]) * rsd[3] * lg[e] + lb[e];
                v2u w; w.x = pg8::cvt_pk_bf16(y0, y1); w.y = pg8::cvt_pk_bf16(y2, y3);
                *(LAS v2u*)(lds + (lane + 64 * e) * VV_STRIDE + s * 2) = w; }
        }
    }
    SGU_WLOAD1(wfA[2], 2); SGU_WLOAD1(wfA[3], 3);
#pragma unroll
    for (int h = 4; h < 8; ++h)
#pragma unroll
        for (int ct = 0; ct < 4; ++ct) uw[h][ct] = *(const v2u*)(z + orow * INW + 768 + 64 * h + 16 * ct + 4 * g);
    __syncthreads();
    float ssq = 0.f;
    v2u opk[8][4];
#define SGU_GROUP(h_, wfx_, HU_) do { \
        const float bias = biasv[HU_]; \
        _Pragma("unroll") for (int ct = 0; ct < 4; ++ct) { \
            f32x4 acc = (f32x4){0.f, 0.f, 0.f, 0.f}; \
            _Pragma("unroll") for (int ks = 0; ks < 4; ++ks) { \
                const LAS unsigned char* vp = lds + (64 * (h_) + 16 * ct + i) * VV_STRIDE + (32 * ks + 8 * g) * 2; \
                acc = __builtin_amdgcn_mfma_f32_16x16x32_bf16(*(const LAS bf16x8*)vp, wfx_[ks], acc, 0, 0, 0); } \
            const int col = 64 * (h_) + 16 * ct + 4 * g; const v2u uu = uw[HU_][ct]; \
            f32x4 o; o[0] = __uint_as_float(uu.x << 16) * (acc[0] + bias); o[1] = __uint_as_float(uu.x & 0xffff0000u) * (acc[1] + bias); \
            o[2] = __uint_as_float(uu.y << 16) * (acc[2] + bias); o[3] = __uint_as_float(uu.y & 0xffff0000u) * (acc[3] + bias); \
            ssq += pg8::dot4(o); \
            v2u w; w.x = pg8::cvt_pk_bf16(o[0], o[1]); w.y = pg8::cvt_pk_bf16(o[2], o[3]); opk[HU_][ct] = w; (void)col; } \
        if ((h_) < 4) SGU_WLOAD1(wfx_, (h_) + 4); } while (0)
    SGU_GROUP(0, wfA[0], 0); SGU_GROUP(1, wfA[1], 1); SGU_GROUP(2, wfA[2], 2); SGU_GROUP(3, wfA[3], 3);
    SGU_GROUP(4, wfA[0], 4); SGU_GROUP(5, wfA[1], 5); SGU_GROUP(6, wfA[2], 6); SGU_GROUP(7, wfA[3], 7);
#undef SGU_GROUP
#undef SGU_WLOAD4
#undef SGU_WLOAD1
    ssq += __shfl_xor(ssq, 16); ssq += __shfl_xor(ssq, 32);
    const float ms_a = ssq_a * (1.0f / 512.0f) + 1e-6f;
    if (g == 0) rsa[orow] = __builtin_amdgcn_rsqf(ms_a);
    const float rs = __builtin_amdgcn_rsqf(ssq * (1.0f / 512.0f) + 1e-6f) * __builtin_amdgcn_sqrtf(ms_a);
#pragma unroll
    for (int h = 0; h < 8; ++h)
#pragma unroll
        for (int ct = 0; ct < 4; ++ct) { const v2u w = opk[h][ct];
            v2u o; o.x = pg8::cvt_pk_bf16(__uint_as_float(w.x << 16) * rs, __uint_as_float(w.x & 0xffff0000u) * rs); o.y = pg8::cvt_pk_bf16(__uint_as_float(w.y << 16) * rs, __uint_as_float(w.y & 0xffff0000u) * rs);
            *(v2u*)(merged + orow * 1024 + 512 + 64 * h + 16 * ct + 4 * g) = o; }
    __syncthreads();
}

typedef const char __attribute__((address_space(4)))* kaptr_t;
#define KA_IN(k) (*(const float* const __attribute__((address_space(4)))*)(ka + 8 * (k)))
#define KA_OUT   (*(float* const __attribute__((address_space(4)))*)(ka + 8 * 21))
#define KA_WS    (*(unsigned char* const __attribute__((address_space(4)))*)(ka + 8 * 22))
#define KA_FENCE() asm volatile("" : "+s"(ka))
#ifndef P4_WGM
#define P4_WGM 4
#endif
#ifndef SEAM
#define SEAM() xcd_barrier(bar)
#endif
__global__ void __launch_bounds__(NWAVES * 64, 2) hymba_fwd(Args args) {
    extern __shared__ __attribute__((aligned(16))) unsigned char lds_[];
    LAS unsigned char* lds = (LAS unsigned char*)lds_;
    kaptr_t ka = (kaptr_t)__builtin_amdgcn_kernarg_segment_ptr();
    const int tid = threadIdx.x, lane = tid & 63, wid = __builtin_amdgcn_readfirstlane(tid >> 6);
    const int G = gridDim.x, bx = blockIdx.x;
    const int gw = bx * NWAVES + wid, NGW = G * NWAVES;
    volatile LAS unsigned* MISC = (volatile LAS unsigned*)(lds + MISC_OFF);
    if (tid < 32) MISC[tid] = 0u;
    __syncthreads();
    XcdBarrier bar = xcd_barrier_post((unsigned*)(KA_WS + WS_CTL), MISC + 8);
    if (G == 0x7fffffff) cg::this_grid().sync();

#ifndef SKIP_P0
    {
        KA_FENCE(); unsigned char* ws = KA_WS;
        LAS float* scr = (LAS float*)(lds + wid * 16384);
        constexpr int I_IN = 16 * 56, I_OUT = 16 * 32, I_UP = 16 * 176, I_DOWN = 44 * 32, I_GATE = 16 * 32, I_PROJ = 4 * 32;
        constexpr int NITEMS = I_IN + I_OUT + I_UP + I_DOWN + I_GATE + I_PROJ;
        for (int it = gw; it < NITEMS; it += NGW) {
            int r = it;
            if (r < I_IN) { p0_transpose_item(KA_IN(3), D, INW, (bf16*)(ws + WS_WIN), KA_IN(2), false, scr, r, lane); continue; } r -= I_IN;
            if (r < I_OUT) { const int kb = r / 32; p0_transpose_item(KA_IN(11), D, D, (bf16*)(ws + WS_WOUT), kb < 8 ? KA_IN(9) : KA_IN(10) - 512, false, scr, r, lane); continue; } r -= I_OUT;
            if (r < I_UP) { p0_transpose_item(KA_IN(13), D, 2 * DFF, (bf16*)(ws + WS_WUP), KA_IN(12), true, scr, r, lane); continue; } r -= I_UP;
            if (r < I_DOWN) { p0_transpose_item(KA_IN(16), DFF, D, (bf16*)(ws + WS_WDOWN), nullptr, false, scr, r, lane); continue; } r -= I_DOWN;
            if (r < I_GATE) { p0_transpose_item(KA_IN(18), D, D, (bf16*)(ws + WS_WGATE), KA_IN(17), false, scr, r, lane); continue; } r -= I_GATE;
            p0_transpose_item(KA_IN(19), PLE, D, (bf16*)(ws + WS_WPROJ), nullptr, false, scr, r, lane);
        }
        { const float* sgw = KA_IN(7); bf16* SW = (bf16*)(ws + WS_SGUW);
          for (int idx = gw * 64 + lane; idx < 8 * 128 * 128 / 4; idx += NGW * 64) { const f32x4 v = *((const f32x4*)sgw + idx); v2u w; w.x = pg8::cvt_pk_bf16(v[0], v[1]); w.y = pg8::cvt_pk_bf16(v[2], v[3]); *((v2u*)SW + idx) = w; } }
        const float* x = KA_IN(0); const float* pin = KA_IN(1); float* rstd1 = (float*)(ws + WS_RSTD1); bf16* XB = (bf16*)(ws + WS_XB); bf16* PB = (bf16*)(ws + WS_PB);
        f32x4 v[2][4], pv[2], vn[2][4], pvn[2];
#define P0_LOAD(dst, pdst, m0_) do { _Pragma("unroll") for (int t = 0; t < 2; ++t) { const int m = (m0_) + t * NGW; const f32x4* xr = (const f32x4*)(x + (size_t)m * D) + lane; \
            _Pragma("unroll") for (int j = 0; j < 4; ++j) dst[t][j] = xr[64 * j]; \
            pdst[t] = *((const f32x4*)(pin + (size_t)m * PLE) + lane); } } while (0)
        P0_LOAD(vn, pvn, gw);
#pragma unroll 1
        for (int m0 = gw; m0 < M; m0 += 2 * NGW) {
            float s[2];
#pragma unroll
            for (int t = 0; t < 2; ++t) { pv[t] = pvn[t];
#pragma unroll
                for (int j = 0; j < 4; ++j) v[t][j] = vn[t][j]; }
            { const int mn = (m0 + 2 * NGW < M) ? m0 + 2 * NGW : gw; P0_LOAD(vn, pvn, mn); }
#pragma unroll
            for (int t = 0; t < 2; ++t) { s[t] = 0.f;
#pragma unroll
                for (int j = 0; j < 4; ++j) s[t] += pg8::dot4(v[t][j]); }
#pragma unroll
            for (int o = 1; o < 64; o <<= 1) { s[0] += __shfl_xor(s[0], o); s[1] += __shfl_xor(s[1], o); }
#pragma unroll
            for (int t = 0; t < 2; ++t) { const int m = m0 + t * NGW;
                if (lane == 0) rstd1[m] = __builtin_amdgcn_rsqf(s[t] * (1.0f / 1024.0f) + 1e-6f);
                v2u* o8 = (v2u*)(XB + (size_t)m * D) + lane;
#pragma unroll
                for (int j = 0; j < 4; ++j) { v2u w; w.x = pg8::cvt_pk_bf16(v[t][j][0], v[t][j][1]); w.y = pg8::cvt_pk_bf16(v[t][j][2], v[t][j][3]); o8[64 * j] = w; }
                v2u w; w.x = pg8::cvt_pk_bf16(pv[t][0], pv[t][1]); w.y = pg8::cvt_pk_bf16(pv[t][2], pv[t][3]); *((v2u*)(PB + (size_t)m * PLE) + lane) = w; }
        }
#undef P0_LOAD
    }
#endif
    SEAM();

#ifndef SKIP_P1
#ifndef SKIP_P1A
    {
        KA_FENCE(); unsigned char* ws = KA_WS;
        pg8::Gemm g{(bf16*)(ws + WS_XB), (bf16*)(ws + WS_WIN), M, INW, D}; pg8::StaticOrder S; S.init(M, INW, G, bx);
        pg8::EpiIn E{(bf16*)(ws + WS_Z), (const float*)(ws + WS_RSTD1)};
        pg8::gemm_phase<pg8::EpiIn, pg8::StaticOrder, true, true>(lds, g, S, E);
    }
#endif
#ifndef SKIP_P1B
    {
        KA_FENCE(); unsigned char* ws = KA_WS;
        int kp = PLE; asm volatile("" : "+s"(kp));
        pg8::Gemm g{(bf16*)(ws + WS_PB), (bf16*)(ws + WS_WPROJ), M, D, kp}; pg8::BalancedOrder S; S.init(M, D, G, bx);
        pg8::EpiPlain E{(bf16*)(ws + WS_PP), D};
        pg8::gemm_phase<pg8::EpiPlain, pg8::BalancedOrder, true, true>(lds, g, S, E);
    }
#endif
#endif
    SEAM();

#ifndef SKIP_P2
    {
#pragma unroll 1
        for (int u = bx; u < 256; u += G) {
            float ssq_a;
            { KA_FENCE(); unsigned char* ws = KA_WS;
              ssq_a = attn_unit(lds, (const bf16*)(ws + WS_Z), (bf16*)(ws + WS_MERGED), KA_IN(4), u >> 4, u & 15, tid, wid, lane); }
            asm volatile("" : "+v"(ssq_a) :: "memory");
            { KA_FENCE(); unsigned char* ws = KA_WS; int tid2 = tid; asm volatile("" : "+v"(tid2));
              const int lane2 = tid2 & 63, wid2 = __builtin_amdgcn_readfirstlane(tid2 >> 6);
              sgu_unit(lds, (const bf16*)(ws + WS_Z), (bf16*)(ws + WS_MERGED), KA_IN(5), KA_IN(6), (const bf16*)(ws + WS_SGUW), KA_IN(8), ssq_a, (float*)(ws + WS_RSTD1), u >> 4, u & 15, tid2, wid2, lane2); }
        }
    }
#endif
    SEAM();

#ifndef SKIP_P3
    {
        KA_FENCE(); unsigned char* ws = KA_WS;
        pg8::Gemm g{(bf16*)(ws + WS_MERGED), (bf16*)(ws + WS_WOUT), M, D, D}; pg8::StaticOrder S; S.init(M, D, G, bx);
        pg8::EpiRes<true, true> E{(const bf16*)(ws + WS_XB), (bf16*)(ws + WS_H1B), (float*)(ws + WS_SSQ1), (const float*)(ws + WS_RSTD1)};
        pg8::gemm_phase<pg8::EpiRes<true, true>, pg8::StaticOrder, true, true>(lds, g, S, E);
    }
#endif
    SEAM();

#ifndef SKIP_P4
    {
        KA_FENCE(); unsigned char* ws = KA_WS;
        pg8::Gemm g{(bf16*)(ws + WS_H1B), (bf16*)(ws + WS_WUP), M, 2 * DFF, D}; pg8::StaticOrder S; S.init(M, 2 * DFF, G, bx, P4_WGM);
        pg8::EpiGlu E{(bf16*)(ws + WS_ACT), (const float*)(ws + WS_SSQ1), KA_IN(14), KA_IN(15), (float*)(ws + WS_SIDE)};
        pg8::gemm_phase<pg8::EpiGlu, pg8::StaticOrder, true, true>(lds, g, S, E);
    }
#endif
    SEAM();

#ifndef SKIP_P4B
    {
        KA_FENCE(); unsigned char* ws = KA_WS;
        const float* conv_w = KA_IN(14); const float* SIDE = (const float*)(ws + WS_SIDE); bf16* ACT = (bf16*)(ws + WS_ACT);
        const int nth = G * 512;
        for (int idx = bx * 512 + tid; idx < 512 * 2 * 704; idx += nth) {
            const int q = idx % 704, gwh = idx / 704, which = gwh & 1, grp = gwh >> 1, ch = 4 * q;
            const int row = 64 * grp + (which ? 63 : 0);
            const f32x4 sp = *(const f32x4*)(SIDE + (size_t)(gwh * 3 + 0) * DFF + ch), vl = *(const f32x4*)(SIDE + (size_t)(gwh * 3 + 1) * DFF + ch);
            f32x4 ext = (f32x4){0.f, 0.f, 0.f, 0.f};
            if (which) { if (((row + 1) & (SEQ - 1)) != 0) ext = *(const f32x4*)(SIDE + (size_t)(((grp + 1) * 2 + 0) * 3 + 2) * DFF + ch); }
            else       { if ((row & (SEQ - 1)) != 0)       ext = *(const f32x4*)(SIDE + (size_t)(((grp - 1) * 2 + 1) * 3 + 2) * DFF + ch); }
            const f32x4 w = *(const f32x4*)(conv_w + (which ? 2 * DFF : 0) + ch);
            const f32x4 a = pg8::gelu4(sp + w * ext) * vl;
            v2u o; o.x = pg8::cvt_pk_bf16(a[0], a[1]); o.y = pg8::cvt_pk_bf16(a[2], a[3]);
            *(v2u*)(ACT + (size_t)row * DFF + ch) = o;
        }
    }
#endif
    SEAM();

#ifndef SKIP_P5
    {
        KA_FENCE(); unsigned char* ws = KA_WS;
        pg8::Gemm g{(bf16*)(ws + WS_ACT), (bf16*)(ws + WS_WDOWN), M, D, DFF}; pg8::StaticOrder S; S.init(M, D, G, bx);
        pg8::EpiRes<true, false> E{(const bf16*)(ws + WS_H1B), (bf16*)(ws + WS_H2B), (float*)(ws + WS_SSQ2), nullptr};
        pg8::gemm_phase<pg8::EpiRes<true, false>, pg8::StaticOrder, true, true>(lds, g, S, E);
    }
#endif
    SEAM();

#ifndef SKIP_P6
    {
        KA_FENCE(); unsigned char* ws = KA_WS;
        pg8::Gemm g{(bf16*)(ws + WS_H2B), (bf16*)(ws + WS_WGATE), M, D, D}; pg8::StaticOrder S; S.init(M, D, G, bx);
        pg8::EpiPle E{(const bf16*)(ws + WS_H2B), (const bf16*)(ws + WS_PP), KA_OUT, (const float*)(ws + WS_SSQ2), (float*)(ws + WS_SSQ3), (unsigned*)(ws + WS_CNT), KA_IN(20)};
        pg8::gemm_phase<pg8::EpiPle, pg8::StaticOrder, true, true>(lds, g, S, E);
    }
#endif
}

extern "C" void kernel_launch(void* const* d_in, const int* in_sizes, int n_in, void* d_out, int out_size, void* d_ws, size_t ws_size, hipStream_t stream) {
    static int grid = 0;
    if (grid == 0) {
        if (n_in != 21 || in_sizes[0] != M * D || out_size != M * D || ws_size < WS_END) { fprintf(stderr, "kernel_launch: unexpected shapes / workspace (n_in %d, in0 %d, out %d, ws %zu)\n", n_in, n_in > 0 ? in_sizes[0] : -1, out_size, ws_size); grid = -1; return; }
        int dev = 0, cus = 0, per_cu = 0;
        if (hipGetDevice(&dev) != hipSuccess || hipDeviceGetAttribute(&cus, hipDeviceAttributeMultiprocessorCount, dev) != hipSuccess) { grid = -1; return; }
        if (hipFuncSetAttribute((const void*)hymba_fwd, hipFuncAttributeMaxDynamicSharedMemorySize, LDS_BYTES) != hipSuccess) { fprintf(stderr, "kernel_launch: hipFuncSetAttribute failed\n"); grid = -1; return; }
        if (hipOccupancyMaxActiveBlocksPerMultiprocessor(&per_cu, (const void*)hymba_fwd, NWAVES * 64, LDS_BYTES) != hipSuccess || per_cu < 1) { fprintf(stderr, "kernel_launch: occupancy query failed (%d)\n", per_cu); (void)hipGetLastError(); grid = -1; return; }
        grid = cus;
    }
    if (grid < 0) return;
    (void)hipMemsetAsync((unsigned char*)d_ws + WS_CTL, 0, CTL_BYTES, stream);
    Args a{};
    for (int i = 0; i < 21; ++i) a.in[i] = (const float*)d_in[i];
    a.out = (float*)d_out; a.ws = (unsigned char*)d_ws;
    void* kargs[] = {&a};
    hipError_t e = hipLaunchCooperativeKernel((const void*)hymba_fwd, dim3(grid), dim3(NWAVES * 64), kargs, LDS_BYTES, stream);
    if (e != hipSuccess) fprintf(stderr, "kernel_launch: cooperative launch failed: %s (grid %d)\n", hipGetErrorString(e), grid);
}
```
